# Optimizing an MI355X kernel written in HIP

```python
import jax, jax.numpy as jnp
from jax import lax
import numpy as np

D_MODEL = 2048
BATCH = 4
SEQ = 2048
DEPTH = 1
DEC_BATCH = 128
DEC_SEQ = 1
PAST_LEN = 8192
PAGE_SIZE = 128

HEAD_DIM = 64
MIX_WIDTH = D_MODEL
RWKV_WIDTH = MIX_WIDTH // 2
ATTN_WIDTH = MIX_WIDTH - RWKV_WIDTH
N_RWKV_HEADS = RWKV_WIDTH // HEAD_DIM
N_Q_HEADS = ATTN_WIDTH // HEAD_DIM
N_KV_HEADS = N_Q_HEADS // 4
GQA_GROUP = N_Q_HEADS // N_KV_HEADS
KV_WIDTH = N_KV_HEADS * HEAD_DIM
WINDOW = 128
ATTN_BLOCK = 128
DECAY_LORA = 64
ICLR_LORA = 64
GATE_LORA = 160
D_FF = 5504
RMS_EPS = 1e-6
GN_EPS = 64e-5
NEG_INF = -1e30
ATTN_PROJ = ATTN_WIDTH + 2 * KV_WIDTH
SHIFT_WIDTH = 3 * RWKV_WIDTH + DECAY_LORA + ICLR_LORA + GATE_LORA
IN_PROJ = ATTN_PROJ + SHIFT_WIDTH

kernel_name = 'hymba_rwkv7_swa_sink_alibi_macaron_step'


def _rmsnorm(x, g):
    xf = x.astype(jnp.float32)
    y = xf * lax.rsqrt(jnp.mean(xf * xf, axis=-1, keepdims=True) + RMS_EPS)
    return (y * g.astype(jnp.float32)).astype(x.dtype)


def _swiglu(x, w_gate, w_up, w_down):
    return (jax.nn.silu(x @ w_gate) * (x @ w_up)) @ w_down


def _alibi_slopes():
    return jnp.exp2(-8.0 * jnp.arange(1, N_Q_HEADS + 1, dtype=jnp.float32) / N_Q_HEADS)


def _window_attention(q, k, v, valid, dist, sinks):
    s = jnp.einsum('...qcgd,...kcd->...cgqk', q, k).astype(jnp.float32) * (HEAD_DIM ** -0.5)
    slopes = _alibi_slopes().reshape(N_KV_HEADS, GQA_GROUP, 1, 1)
    s = jnp.where(valid, s - slopes * dist.astype(jnp.float32), NEG_INF)
    sink = jnp.broadcast_to(sinks.astype(jnp.float32).reshape(N_KV_HEADS, GQA_GROUP, 1, 1), s.shape[:-1] + (1,))
    p = jax.nn.softmax(jnp.concatenate([s, sink], axis=-1), axis=-1)[..., :-1]
    return jnp.einsum('...cgqk,...kcd->...qcgd', p.astype(v.dtype), v)


def _swa_prompt(q, k, v, sinks):
    B, T = q.shape[:2]
    nb = T // ATTN_BLOCK
    qb = q.reshape(B, nb, ATTN_BLOCK, N_KV_HEADS, GQA_GROUP, HEAD_DIM)

    def banded(t):
        tb = t.reshape(B, nb, ATTN_BLOCK, N_KV_HEADS, HEAD_DIM)
        prev = jnp.pad(tb, ((0, 0), (1, 0), (0, 0), (0, 0), (0, 0)))[:, :-1]
        return jnp.concatenate([prev, tb], axis=2)

    kb, vb = banded(k), banded(v)
    qi = jnp.arange(ATTN_BLOCK)[:, None] + ATTN_BLOCK
    kj = jnp.arange(2 * ATTN_BLOCK)[None, :]
    dist = qi - kj
    in_window = (dist >= 0) & (dist < WINDOW)
    has_prev = (jnp.arange(nb) > 0)[:, None, None] | (kj >= ATTN_BLOCK)[None]
    valid = (in_window[None] & has_prev)[:, None, None]
    o = _window_attention(qb, kb, vb, valid, dist, sinks)
    wb = min(WINDOW, T)
    return o.reshape(B, T, ATTN_WIDTH), k[:, T - wb:], v[:, T - wb:]


def _swa_sample(q, k, v, cache_k, cache_v, sinks):
    B, S = q.shape[:2]
    wb = cache_k.shape[1]
    keys = jnp.concatenate([cache_k.astype(k.dtype), k], axis=1)
    vals = jnp.concatenate([cache_v.astype(v.dtype), v], axis=1)
    qpos = PAST_LEN + jnp.arange(S)
    kpos = PAST_LEN - wb + jnp.arange(wb + S)
    dist = qpos[:, None] - kpos[None, :]
    valid = (dist >= 0) & (dist < WINDOW)
    o = _window_attention(q, keys, vals, valid, dist, sinks)
    return o.reshape(B, S, ATTN_WIDTH), keys[:, S:], vals[:, S:]


def _rwkv7_mix(p, shift_prev, wkv0, W):
    B, T, _ = p.shape
    f32 = jnp.float32
    prev = jnp.concatenate([shift_prev[:, None].astype(p.dtype), p[:, :-1]], axis=1)
    u = p + W['rwkv_mu'] * (prev - p)
    r, k, v, dd, da, dg = jnp.split(u, [RWKV_WIDTH, 2 * RWKV_WIDTH, 3 * RWKV_WIDTH,
                                       3 * RWKV_WIDTH + DECAY_LORA,
                                       3 * RWKV_WIDTH + DECAY_LORA + ICLR_LORA], axis=-1)
    w_log = -jax.nn.softplus(-(W['rwkv_decay_base'] + jnp.tanh(dd) @ W['rwkv_decay_up']).astype(f32)) - 0.5
    decay = jnp.exp(-jnp.exp(w_log))
    a = jax.nn.sigmoid((W['rwkv_iclr_base'] + da @ W['rwkv_iclr_up']).astype(f32))
    g = jax.nn.sigmoid(dg) @ W['rwkv_gate_up']

    def heads(t):
        return t.reshape(B, T, N_RWKV_HEADS, HEAD_DIM)

    r32, k32, v32 = heads(r.astype(f32)), heads(k.astype(f32)), heads(v.astype(f32))
    a, decay = heads(a), heads(decay)
    kk = k32 * W['rwkv_k_k'].astype(f32).reshape(N_RWKV_HEADS, HEAD_DIM)
    kk = kk / jnp.maximum(jnp.sqrt(jnp.sum(kk * kk, axis=-1, keepdims=True)), 1e-12)
    k32 = k32 * (1.0 + (a - 1.0) * W['rwkv_k_a'].astype(f32).reshape(N_RWKV_HEADS, HEAD_DIM))

    def step(S, xs):
        r_t, w_t, k_t, v_t, na_t, b_t = xs
        sa = jnp.einsum('bhvk,bhk->bhv', S, na_t)
        S = S * w_t[:, :, None, :] + sa[..., None] * b_t[:, :, None, :] + v_t[..., None] * k_t[:, :, None, :]
        return S, jnp.einsum('bhvk,bhk->bhv', S, r_t)

    xs = tuple(jnp.moveaxis(t, 1, 0) for t in (r32, decay, k32, v32, -kk, kk * a))
    S_T, o = lax.scan(step, wkv0.astype(f32), xs)
    o = jnp.moveaxis(o, 0, 1)
    mean = jnp.mean(o, axis=-1, keepdims=True)
    var = jnp.mean(jnp.square(o - mean), axis=-1, keepdims=True)
    o = (o - mean) * lax.rsqrt(var + GN_EPS)
    o = o * W['rwkv_lnx_g'].astype(f32).reshape(N_RWKV_HEADS, HEAD_DIM) + W['rwkv_lnx_b'].astype(f32).reshape(N_RWKV_HEADS, HEAD_DIM)
    bonus = jnp.sum(r32 * k32 * W['rwkv_r_k'].astype(f32), axis=-1, keepdims=True) * v32
    o = (o + bonus).reshape(B, T, RWKV_WIDTH).astype(p.dtype) * g
    return o, p[:, -1], S_T.astype(wkv0.dtype)


def _layer(x, shift_prev, wkv0, cache_k, cache_v, W):
    B, T, _ = x.shape
    x = x + 0.5 * _swiglu(_rmsnorm(x, W['ffn1_norm']), W['ffn1_w_gate'], W['ffn1_w_up'], W['ffn1_w_down'])
    p = _rmsnorm(x, W['mix_norm']) @ W['w_in']
    q = p[..., :ATTN_WIDTH].reshape(B, T, N_KV_HEADS, GQA_GROUP, HEAD_DIM)
    k = p[..., ATTN_WIDTH:ATTN_WIDTH + KV_WIDTH].reshape(B, T, N_KV_HEADS, HEAD_DIM)
    v = p[..., ATTN_WIDTH + KV_WIDTH:ATTN_PROJ].reshape(B, T, N_KV_HEADS, HEAD_DIM)
    if cache_k is None:
        o_attn, k_win, v_win = _swa_prompt(q, k, v, W['attn_sinks'])
    else:
        o_attn, k_win, v_win = _swa_sample(q, k, v, cache_k, cache_v, W['attn_sinks'])
    o_rwkv, shift_new, wkv_new = _rwkv7_mix(p[..., ATTN_PROJ:], shift_prev, wkv0, W)
    x = x + jnp.concatenate([o_rwkv, o_attn], axis=-1) @ W['w_out']
    x = x + 0.5 * _swiglu(_rmsnorm(x, W['ffn2_norm']), W['ffn2_w_gate'], W['ffn2_w_up'], W['ffn2_w_down'])
    return x, shift_new, wkv_new, k_win, v_win


def setup_inputs(seed: int = 0) -> dict:
    key = jax.random.key(seed)
    ks = iter(jax.random.split(key, 40))
    f32 = jnp.float32
    L = DEPTH
    w_buf = min(WINDOW, PAST_LEN)

    def nrm(shape, scale):
        return scale * jax.random.normal(next(ks), shape, f32)

    return {
        'x_prompt': nrm((BATCH, SEQ, D_MODEL), 1.0),
        'x_sample': nrm((DEC_BATCH, DEC_SEQ, D_MODEL), 1.0),
        'state_rwkv_shift': nrm((L, DEC_BATCH, SHIFT_WIDTH), 1.0),
        'state_rwkv_wkv': nrm((L, DEC_BATCH, N_RWKV_HEADS, HEAD_DIM, HEAD_DIM), 0.5),
        'cache_swa_k': nrm((L, DEC_BATCH, w_buf, N_KV_HEADS, HEAD_DIM), 1.0),
        'cache_swa_v': nrm((L, DEC_BATCH, w_buf, N_KV_HEADS, HEAD_DIM), 1.0),
        'ffn1_norm': 1.0 + nrm((L, D_MODEL), 0.01),
        'ffn1_w_gate': nrm((L, D_MODEL, D_FF), D_MODEL ** -0.5),
        'ffn1_w_up': nrm((L, D_MODEL, D_FF), D_MODEL ** -0.5),
        'ffn1_w_down': nrm((L, D_FF, D_MODEL), D_FF ** -0.5),
        'mix_norm': 1.0 + nrm((L, D_MODEL), 0.01),
        'w_in': nrm((L, D_MODEL, IN_PROJ), D_MODEL ** -0.5),
        'rwkv_mu': jax.random.uniform(next(ks), (L, SHIFT_WIDTH), f32),
        'rwkv_decay_up': nrm((L, DECAY_LORA, RWKV_WIDTH), 0.1),
        'rwkv_decay_base': -1.6 + nrm((L, RWKV_WIDTH), 0.5),
        'rwkv_iclr_up': nrm((L, ICLR_LORA, RWKV_WIDTH), 0.1),
        'rwkv_iclr_base': nrm((L, RWKV_WIDTH), 0.1),
        'rwkv_gate_up': nrm((L, GATE_LORA, RWKV_WIDTH), GATE_LORA ** -0.5),
        'rwkv_k_k': 0.85 + nrm((L, RWKV_WIDTH), 0.02),
        'rwkv_k_a': 1.0 + nrm((L, RWKV_WIDTH), 0.02),
        'rwkv_r_k': nrm((L, N_RWKV_HEADS, HEAD_DIM), 0.1),
        'rwkv_lnx_g': 1.0 + nrm((L, RWKV_WIDTH), 0.01),
        'rwkv_lnx_b': nrm((L, RWKV_WIDTH), 0.01),
        'attn_sinks': nrm((L, N_Q_HEADS), 0.5),
        'w_out': nrm((L, MIX_WIDTH, D_MODEL), MIX_WIDTH ** -0.5),
        'ffn2_norm': 1.0 + nrm((L, D_MODEL), 0.01),
        'ffn2_w_gate': nrm((L, D_MODEL, D_FF), D_MODEL ** -0.5),
        'ffn2_w_up': nrm((L, D_MODEL, D_FF), D_MODEL ** -0.5),
        'ffn2_w_down': nrm((L, D_FF, D_MODEL), D_FF ** -0.5),
        'final_norm': 1.0 + nrm((D_MODEL,), 0.01),
    }


def reference(x_prompt, x_sample, state_rwkv_shift, state_rwkv_wkv, cache_swa_k, cache_swa_v,
              ffn1_norm, ffn1_w_gate, ffn1_w_up, ffn1_w_down, mix_norm, w_in,
              rwkv_mu, rwkv_decay_up, rwkv_decay_base, rwkv_iclr_up, rwkv_iclr_base, rwkv_gate_up,
              rwkv_k_k, rwkv_k_a, rwkv_r_k, rwkv_lnx_g, rwkv_lnx_b, attn_sinks, w_out,
              ffn2_norm, ffn2_w_gate, ffn2_w_up, ffn2_w_down, final_norm):
    yp, ys = x_prompt, x_sample
    B = x_prompt.shape[0]
    p_shift, p_wkv, p_k, p_v = [], [], [], []
    s_shift, s_wkv, s_k, s_v = [], [], [], []
    for l in range(DEPTH):
        W = {
            'ffn1_norm': ffn1_norm[l], 'ffn1_w_gate': ffn1_w_gate[l], 'ffn1_w_up': ffn1_w_up[l],
            'ffn1_w_down': ffn1_w_down[l], 'mix_norm': mix_norm[l], 'w_in': w_in[l],
            'rwkv_mu': rwkv_mu[l], 'rwkv_decay_up': rwkv_decay_up[l], 'rwkv_decay_base': rwkv_decay_base[l],
            'rwkv_iclr_up': rwkv_iclr_up[l], 'rwkv_iclr_base': rwkv_iclr_base[l], 'rwkv_gate_up': rwkv_gate_up[l],
            'rwkv_k_k': rwkv_k_k[l], 'rwkv_k_a': rwkv_k_a[l], 'rwkv_r_k': rwkv_r_k[l],
            'rwkv_lnx_g': rwkv_lnx_g[l], 'rwkv_lnx_b': rwkv_lnx_b[l], 'attn_sinks': attn_sinks[l],
            'w_out': w_out[l], 'ffn2_norm': ffn2_norm[l], 'ffn2_w_gate': ffn2_w_gate[l],
            'ffn2_w_up': ffn2_w_up[l], 'ffn2_w_down': ffn2_w_down[l],
        }
        shift0 = jnp.zeros((B, SHIFT_WIDTH), yp.dtype)
        wkv0 = jnp.zeros((B, N_RWKV_HEADS, HEAD_DIM, HEAD_DIM), yp.dtype)
        yp, a1, a2, a3, a4 = _layer(yp, shift0, wkv0, None, None, W)
        ys, b1, b2, b3, b4 = _layer(ys, state_rwkv_shift[l], state_rwkv_wkv[l], cache_swa_k[l], cache_swa_v[l], W)
        p_shift.append(a1); p_wkv.append(a2); p_k.append(a3); p_v.append(a4)
        s_shift.append(b1); s_wkv.append(b2); s_k.append(b3); s_v.append(b4)
    y_prompt = _rmsnorm(yp, final_norm)
    y_sample = _rmsnorm(ys, final_norm)
    return (y_prompt, y_sample,
            jnp.stack(p_shift), jnp.stack(p_wkv), jnp.stack(p_k), jnp.stack(p_v),
            jnp.stack(s_shift), jnp.stack(s_wkv), jnp.stack(s_k), jnp.stack(s_v))
```

```cpp
#include <hip/hip_runtime.h>
#include <cstdio>
#include <cstdint>
#define MK_N_LAUNCHES 1
namespace pg8 {
#define PG8_LAS __attribute__((address_space(3)))
typedef unsigned short bf16_t;
typedef short bf16x8 __attribute__((ext_vector_type(8)));
typedef float f32x4 __attribute__((ext_vector_type(4)));
typedef unsigned u32x4 __attribute__((ext_vector_type(4)));
constexpr int BM = 256, BK = 64, HALF = 128, HTB = HALF * BK * 2  , STAGE_BYTES = 8 * HTB, NXCD = 8, WGM = 8;

__host__ __device__ __forceinline__ int lds_byte(int r, int c) { const int st = (r >> 4) * 2 + (c >> 5), rr = r & 15, cc = c & 31, ob = rr * 64 + cc * 2; return st * 1024 + (ob ^ (((ob >> 9) & 1) << 5)); }
__host__ __device__ __forceinline__ void stage_rc(int b, int& R, int& C) { const int st = b / 1024, sb = b % 1024, swz = sb ^ (((sb >> 9) & 1) << 5); R = (st >> 1) * 16 + swz / 64; C = (st & 1) * 32 + (swz % 64) / 2; }
__host__ __device__ __forceinline__ int perm32(int rho) { const int n = rho >> 4, i = rho & 15; return 8 * (i >> 2) + 4 * n + (i & 3); }

struct Unit { int pm, pn; };
struct Gemm { const bf16_t* A; const bf16_t* Bt; int M, N, K; };

struct StaticOrder {
    int nM, nN, nwg, G, c;
    __host__ __device__ void init(int M, int N, int G_, int c_) { nM = M / BM; nN = N / BM; nwg = nM * nN; G = G_; c = c_; }
    __host__ __device__ bool next(int i, Unit& u) const {
        const long L = (long)i * G + c; if (L >= nwg) return false;
        int wgid = (int)L; { const int q = nwg / NXCD, r = nwg % NXCD, xcd = wgid % NXCD, off = wgid / NXCD; wgid = (xcd < r ? xcd * (q + 1) : r * (q + 1) + (xcd - r) * q) + off; }
        const int nig = WGM * nN, gid = wgid / nig, fm = gid * WGM, gsz = (nM - fm) < WGM ? (nM - fm) : WGM;
        u.pm = fm + ((wgid % nig) % gsz); u.pn = (wgid % nig) / gsz; return true;
    }
    __device__ __forceinline__ void a_ready(const Unit&) const {}
    __device__ __forceinline__ void done(const Unit&) const {}
};

__device__ __forceinline__ unsigned cvt_pk_bf16(float lo, float hi) { unsigned r; asm volatile("v_cvt_pk_bf16_f32 %0, %1, %2" : "=v"(r) : "v"(lo), "v"(hi)); return r; }
typedef unsigned u32x2 __attribute__((ext_vector_type(2)));
constexpr int MVALID = 8320, MPROMPT = 8192, DMODEL = 2048;
__device__ __forceinline__ float rs_row(const float* ss, int row) { return __builtin_amdgcn_rsqf(ss[row] * (1.0f / 2048.0f) + 1e-6f); }
__device__ __forceinline__ float silu_mul(float g, float u) { return g * u * __builtin_amdgcn_rcpf(1.0f + __builtin_amdgcn_exp2f(-1.4426950408889634f * g)); }
__device__ __forceinline__ float sigmoid_f(float x) { return __builtin_amdgcn_rcpf(1.0f + __builtin_amdgcn_exp2f(-1.4426950408889634f * x)); }

struct EpiSwiglu {
    static constexpr bool PERM = true, AFTER_DRAIN = false;
    bf16_t* H; const float* ss; int ldh;
    __device__ __forceinline__ void operator()(const f32x4 (&acc)[2][2][4][2], const Unit& u, int wr, int wc, int fr, int fq) const {
        const int row0 = u.pm * BM + wr * 64 + fr, col0 = u.pn * HALF + wc * 32 + 8 * fq;
#pragma unroll
        for (int ai = 0; ai < 2; ++ai)
#pragma unroll
            for (int m = 0; m < 4; ++m) { const int row = row0 + ai * HALF + m * 16; const float rs = rs_row(ss, row);
                const f32x4 g0 = acc[ai][0][m][0] * rs, g1 = acc[ai][0][m][1] * rs, u0 = acc[ai][1][m][0] * rs, u1 = acc[ai][1][m][1] * rs;
                u32x4 w; w.x = cvt_pk_bf16(silu_mul(g0[0], u0[0]), silu_mul(g0[1], u0[1])); w.y = cvt_pk_bf16(silu_mul(g0[2], u0[2]), silu_mul(g0[3], u0[3]));
                w.z = cvt_pk_bf16(silu_mul(g1[0], u1[0]), silu_mul(g1[1], u1[1])); w.w = cvt_pk_bf16(silu_mul(g1[2], u1[2]), silu_mul(g1[3], u1[3]));
                *(u32x4*)(H + (size_t)row * ldh + col0) = w; }
    }
};
struct EpiResid {
    static constexpr bool PERM = true, AFTER_DRAIN = false;
    const float* xin0; const float* xin1; float* xout; bf16_t* xb; float* ssq; float scale;
    __device__ __forceinline__ void operator()(const f32x4 (&acc)[2][2][4][2], const Unit& u, int wr, int wc, int fr, int fq) const {
        const int row0 = u.pm * BM + wr * 64 + fr, col0 = u.pn * BM + wc * 32 + 8 * fq;
#pragma unroll
        for (int ai = 0; ai < 2; ++ai)
#pragma unroll
            for (int m = 0; m < 4; ++m) { const int row = row0 + ai * HALF + m * 16; const bool valid = row < MVALID;
                const float* xr = (row < MPROMPT ? xin0 + (size_t)row * DMODEL : xin1 + (size_t)(row - MPROMPT) * DMODEL) + col0;
                float part = 0.f;
#pragma unroll
                for (int bj = 0; bj < 2; ++bj) { f32x4 x0 = (f32x4){0.f, 0.f, 0.f, 0.f}, x1 = x0;
                    if (valid) { x0 = *(const f32x4*)(xr + bj * HALF); x1 = *(const f32x4*)(xr + bj * HALF + 4); }
                    const f32x4 v0 = x0 + acc[ai][bj][m][0] * scale, v1 = x1 + acc[ai][bj][m][1] * scale;
                    part += (v0[0] * v0[0] + v0[1] * v0[1]) + (v0[2] * v0[2] + v0[3] * v0[3]) + (v1[0] * v1[0] + v1[1] * v1[1]) + (v1[2] * v1[2] + v1[3] * v1[3]);
                    if (valid) { float* o = xout + (size_t)row * DMODEL + col0 + bj * HALF; *(f32x4*)o = v0; *(f32x4*)(o + 4) = v1; }
                    if (xb) { u32x4 w; w.x = cvt_pk_bf16(v0[0], v0[1]); w.y = cvt_pk_bf16(v0[2], v0[3]); w.z = cvt_pk_bf16(v1[0], v1[1]); w.w = cvt_pk_bf16(v1[2], v1[3]);
                        *(u32x4*)(xb + (size_t)row * DMODEL + col0 + bj * HALF) = w; } }
                part += __shfl_xor(part, 16); part += __shfl_xor(part, 32);
                if (fq == 0) atomicAdd(ssq + row, part); }
    }
};
struct EpiWin {
    static constexpr bool PERM = true, AFTER_DRAIN = false;
    bf16_t* QKV; float* PRW; const float* ss; float* kwin_p; long wins_minus_winp; float qscale;
    __device__ __forceinline__ void operator()(const f32x4 (&acc)[2][2][4][2], const Unit& u, int wr, int wc, int fr, int fq) const {
        const int row0 = u.pm * BM + wr * 64 + fr, c0 = wc * 32 + 8 * fq;
#pragma unroll
        for (int ai = 0; ai < 2; ++ai)
#pragma unroll
            for (int m = 0; m < 4; ++m) { const int row = row0 + ai * HALF + m * 16; const float rs = rs_row(ss, row);
#pragma unroll
                for (int bj = 0; bj < 2; ++bj) { const f32x4 v0 = acc[ai][bj][m][0] * rs, v1 = acc[ai][bj][m][1] * rs; const int c256 = bj * HALF + c0;
                    if (u.pn < 6) { const float sc = u.pn < 4 ? qscale : 1.0f;
                        u32x4 w; w.x = cvt_pk_bf16(v0[0] * sc, v0[1] * sc); w.y = cvt_pk_bf16(v0[2] * sc, v0[3] * sc); w.z = cvt_pk_bf16(v1[0] * sc, v1[1] * sc); w.w = cvt_pk_bf16(v1[2] * sc, v1[3] * sc);
                        *(u32x4*)(QKV + (size_t)row * 1536 + u.pn * BM + c256) = w;
                        if (u.pn >= 4) { long off = -1; const bool isp = row < MPROMPT; const long kv = u.pn - 4;
                            if (isp) { const int t = row & 2047; if (t >= 1920) off = kv * 131072 + (long)((row >> 11) * 128 + (t - 1920)) * 256 + c256; }
                            else if (row < MVALID) off = (long)(wins_minus_winp) + kv * 4194304 + (long)((row - MPROMPT) * 128 + 127) * 256 + c256;
                            if (off >= 0) { *(f32x4*)(kwin_p + off) = v0; *(f32x4*)(kwin_p + off + 4) = v1; } }
                    } else { float* o = PRW + (size_t)row * 3584 + (u.pn - 6) * BM + c256; *(f32x4*)o = v0; *(f32x4*)(o + 4) = v1; } } }
    }
};
struct EpiLora {
    static constexpr bool PERM = true, AFTER_DRAIN = false;
    float* LWW; long lwa_minus_lww; bf16_t* LWG; const float* dbase; long ibase_minus_dbase;
    __device__ __forceinline__ void operator()(const f32x4 (&acc)[2][2][4][2], const Unit& u, int wr, int wc, int fr, int fq) const {
        const int row0 = u.pm * BM + wr * 64 + fr, seg = u.pn >> 2, cb = (u.pn & 3) * BM + wc * 32 + 8 * fq;
#pragma unroll
        for (int bj = 0; bj < 2; ++bj) { const int col = cb + bj * HALF;
            f32x4 b0 = (f32x4){0.f, 0.f, 0.f, 0.f}, b1 = b0;
            if (seg < 2) { const float* bp = dbase + (seg ? ibase_minus_dbase : 0) + col; b0 = *(const f32x4*)bp; b1 = *(const f32x4*)(bp + 4); }
#pragma unroll
            for (int ai = 0; ai < 2; ++ai)
#pragma unroll
                for (int m = 0; m < 4; ++m) { const int row = row0 + ai * HALF + m * 16; const f32x4 v0 = acc[ai][bj][m][0] + b0, v1 = acc[ai][bj][m][1] + b1;
                    if (seg == 2) { u32x4 w; w.x = cvt_pk_bf16(v0[0], v0[1]); w.y = cvt_pk_bf16(v0[2], v0[3]); w.z = cvt_pk_bf16(v1[0], v1[1]); w.w = cvt_pk_bf16(v1[2], v1[3]);
                        *(u32x4*)(LWG + (size_t)row * 1024 + col) = w; }
                    else { float* o = LWW + (seg ? lwa_minus_lww : 0) + (size_t)row * 1024 + col; *(f32x4*)o = v0; *(f32x4*)(o + 4) = v1; } } }
    }
};
template <class Epi, class Sched, bool ALIGN_EPI = false, bool SP2 = false>
__device__ __forceinline__ void gemm_phase(PG8_LAS unsigned char* lds, const Gemm g, const Sched& S, const Epi& E) {
    const int tid = threadIdx.x, wid = __builtin_amdgcn_readfirstlane(tid >> 6), lane = tid & 63, wr = wid >> 2, wc = wid & 3, fr = lane & 15, fq = lane >> 4;
    const int K = g.K, nt = K / BK;
    unsigned voffA[2], voffB[2];
#pragma unroll
    for (int i = 0; i < 2; ++i) { int R, C; stage_rc(tid * 16 + i * 8192, R, C); const int Rb = Epi::PERM ? ((R & ~31) + perm32(R & 31)) : R;
        voffA[i] = (unsigned)(R * K + C) * 2u; voffB[i] = (unsigned)(Rb * K + C) * 2u; }
    const size_t kstep = (size_t)(BK * 2);
    const size_t hstep = (size_t)HALF * K * 2;
    const size_t tstep = 2 * hstep;
    const unsigned ldsw = (unsigned)wid * 1024u;
    const int aoff = lds_byte(wr * 64 + fr, fq * 8), boff = lds_byte(wc * 32 + fr, fq * 8);
#define PG8_SA(b, h) (((b) * 2 + (h)) * HTB)
#define PG8_SB(b, h) ((4 + (b) * 2 + (h)) * HTB)
#define PG8_STAGE(bufoff, gbase, voff) do { _Pragma("unroll") for (int _i = 0; _i < 2; ++_i) \
        __builtin_amdgcn_global_load_lds((const unsigned*)((const char*)(gbase) + (voff)[_i]), (PG8_LAS unsigned*)(lds + (bufoff) + ldsw + _i * 8192), 16, 0, 0); } while (0)
#define PG8_LDA(dst, b, h) do { _Pragma("unroll") for (int m = 0; m < 4; ++m) _Pragma("unroll") for (int k = 0; k < 2; ++k) dst[m][k] = *(const PG8_LAS bf16x8*)(lds + PG8_SA(b, h) + aoff + m * 2048 + k * 1024); } while (0)
#define PG8_LDB(dst, b, h) do { _Pragma("unroll") for (int n = 0; n < 2; ++n) _Pragma("unroll") for (int k = 0; k < 2; ++k) dst[n][k] = *(const PG8_LAS bf16x8*)(lds + PG8_SB(b, h) + boff + n * 2048 + k * 1024); } while (0)
#define PG8_MMA(ai, bj, At, Bt) do { __builtin_amdgcn_s_setprio(1); _Pragma("unroll") for (int m = 0; m < 4; ++m) _Pragma("unroll") for (int n = 0; n < 2; ++n) _Pragma("unroll") for (int k = 0; k < 2; ++k) \
        acc[ai][bj][m][n] = __builtin_amdgcn_mfma_f32_16x16x32_bf16(Bt[n][k], At[m][k], acc[ai][bj][m][n], 0, 0, 0); __builtin_amdgcn_s_setprio(0); } while (0)
#define PG8_WAIT_V(n) asm volatile("s_waitcnt vmcnt(" #n ")" ::: "memory")
#define PG8_WAIT_L(n) asm volatile("s_waitcnt lgkmcnt(" #n ")" ::: "memory")
#define PG8_BAR __builtin_amdgcn_s_barrier()
#define PG8_SCHED __builtin_amdgcn_sched_barrier(0)
    Unit cur, nxt; int ui = 0;
    if (!S.next(0, cur)) return;
    f32x4 acc[2][2][4][2];
#pragma unroll
    for (int a = 0; a < 2; ++a)
#pragma unroll
        for (int b = 0; b < 2; ++b)
#pragma unroll
            for (int m = 0; m < 4; ++m)
#pragma unroll
                for (int n = 0; n < 2; ++n) acc[a][b][m][n] = (f32x4){0.f, 0.f, 0.f, 0.f};
    bf16x8 At[4][2], B0[2][2], B1[2][2];
    const char* cA = (const char*)g.A + (size_t)cur.pm * tstep; const char* cB = (const char*)g.Bt + (size_t)cur.pn * tstep;
    S.a_ready(cur);
    if constexpr (SP2) {
        PG8_STAGE(PG8_SB(0, 0), cB, voffB); PG8_STAGE(PG8_SB(0, 1), cB + hstep, voffB); PG8_STAGE(PG8_SA(0, 0), cA, voffA); PG8_STAGE(PG8_SA(0, 1), cA + hstep, voffA);
        if (wr == 1) PG8_BAR;
        PG8_WAIT_V(2); PG8_BAR;
        PG8_STAGE(PG8_SB(1, 0), cB + kstep, voffB); PG8_STAGE(PG8_SA(1, 0), cA + kstep, voffA); PG8_STAGE(PG8_SB(1, 1), cB + hstep + kstep, voffB);
        PG8_WAIT_V(6); PG8_BAR;
    } else {
        PG8_STAGE(PG8_SB(0, 0), cB, voffB); PG8_STAGE(PG8_SA(0, 0), cA, voffA); PG8_STAGE(PG8_SB(0, 1), cB + hstep, voffB); PG8_STAGE(PG8_SA(0, 1), cA + hstep, voffA);
        if (wr == 1) PG8_BAR;
        PG8_WAIT_V(4); PG8_BAR;
        PG8_STAGE(PG8_SB(1, 0), cB + kstep, voffB); PG8_STAGE(PG8_SA(1, 0), cA + kstep, voffA); PG8_STAGE(PG8_SB(1, 1), cB + hstep + kstep, voffB);
        PG8_WAIT_V(6); PG8_BAR;
    }
    for (;;) {
        const bool has_next = S.next(ui + 1, nxt);
        const char* nA = has_next ? (const char*)g.A + (size_t)nxt.pm * tstep : cA; const char* nB = has_next ? (const char*)g.Bt + (size_t)nxt.pn * tstep : cB;
#pragma unroll 1
        for (int t = 0; t < nt; t += 2) {
            const bool last = (t == nt - 2);
            const char* a1 = cA + (size_t)(t + 1) * kstep;
            const char* a2 = last ? nA : cA + (size_t)(t + 2) * kstep; const char* b2 = last ? nB : cB + (size_t)(t + 2) * kstep;
            const char* a3 = a2 + kstep; const char* b3 = b2 + kstep;
            if (last && has_next) S.a_ready(nxt);
            if constexpr (SP2) {
            PG8_LDB(B0, 0, 0); PG8_LDB(B1, 0, 1); PG8_SCHED; PG8_LDA(At, 0, 0); PG8_STAGE(PG8_SA(1, 1), a1 + hstep, voffA);
            PG8_WAIT_V(8); PG8_WAIT_L(0); PG8_BAR; PG8_MMA(0, 0, At, B0); PG8_MMA(0, 1, At, B1); PG8_BAR; PG8_SCHED;
            PG8_LDA(At, 0, 1); PG8_STAGE(PG8_SB(0, 0), b2, voffB); PG8_STAGE(PG8_SB(0, 1), b2 + hstep, voffB); PG8_STAGE(PG8_SA(0, 0), a2, voffA);
            PG8_WAIT_V(8); PG8_WAIT_L(0); PG8_BAR; PG8_MMA(1, 0, At, B0); PG8_MMA(1, 1, At, B1); PG8_BAR; PG8_SCHED;
            PG8_LDB(B0, 1, 0); PG8_LDB(B1, 1, 1); PG8_SCHED; PG8_LDA(At, 1, 0); PG8_STAGE(PG8_SA(0, 1), a2 + hstep, voffA);
            PG8_WAIT_V(8); PG8_WAIT_L(0); PG8_BAR; PG8_MMA(0, 0, At, B0); PG8_MMA(0, 1, At, B1); PG8_BAR; PG8_SCHED;
            PG8_LDA(At, 1, 1); PG8_STAGE(PG8_SB(1, 0), b3, voffB); PG8_STAGE(PG8_SB(1, 1), b3 + hstep, voffB); PG8_STAGE(PG8_SA(1, 0), a3, voffA);
            PG8_WAIT_V(8); PG8_WAIT_L(0); PG8_BAR; PG8_MMA(1, 0, At, B0); PG8_MMA(1, 1, At, B1); PG8_BAR; PG8_SCHED;
            } else {
            PG8_LDB(B0, 0, 0); PG8_SCHED; PG8_LDA(At, 0, 0); PG8_STAGE(PG8_SA(1, 1), a1 + hstep, voffA);
            PG8_WAIT_L(8); PG8_BAR; PG8_WAIT_L(0); PG8_MMA(0, 0, At, B0); PG8_BAR; PG8_SCHED;
            PG8_LDB(B1, 0, 1); PG8_STAGE(PG8_SB(0, 0), b2, voffB);
            PG8_BAR; PG8_WAIT_L(0); PG8_MMA(0, 1, At, B1); PG8_BAR;
            PG8_LDA(At, 0, 1); PG8_STAGE(PG8_SA(0, 0), a2, voffA);
            PG8_BAR; PG8_WAIT_L(0); PG8_MMA(1, 0, At, B0); PG8_BAR; PG8_SCHED;
            PG8_STAGE(PG8_SB(0, 1), b2 + hstep, voffB);
            PG8_WAIT_V(6); PG8_BAR; PG8_MMA(1, 1, At, B1); PG8_BAR;
            PG8_LDB(B0, 1, 0); PG8_SCHED; PG8_LDA(At, 1, 0); PG8_STAGE(PG8_SA(0, 1), a2 + hstep, voffA);
            PG8_WAIT_L(8); PG8_BAR; PG8_WAIT_L(0); PG8_MMA(0, 0, At, B0); PG8_BAR; PG8_SCHED;
            PG8_LDB(B1, 1, 1); PG8_STAGE(PG8_SB(1, 0), b3, voffB);
            PG8_BAR; PG8_WAIT_L(0); PG8_MMA(0, 1, At, B1); PG8_BAR;
            PG8_LDA(At, 1, 1); PG8_STAGE(PG8_SA(1, 0), a3, voffA);
            PG8_BAR; PG8_WAIT_L(0); PG8_MMA(1, 0, At, B0); PG8_BAR; PG8_SCHED;
            PG8_STAGE(PG8_SB(1, 1), b3 + hstep, voffB);
            PG8_WAIT_V(6); PG8_BAR; PG8_MMA(1, 1, At, B1); PG8_BAR;
            }
        }
        if constexpr (ALIGN_EPI) { if (wr == 0) PG8_BAR; }
        if constexpr (!Epi::AFTER_DRAIN) { E(acc, cur, wr, wc, fr, fq); S.done(cur); }
        if (!has_next) break;
#pragma unroll
        for (int a = 0; a < 2; ++a)
#pragma unroll
            for (int b = 0; b < 2; ++b)
#pragma unroll
                for (int m = 0; m < 4; ++m)
#pragma unroll
                    for (int n = 0; n < 2; ++n) acc[a][b][m][n] = (f32x4){0.f, 0.f, 0.f, 0.f};
        cur = nxt; cA = nA; cB = nB; ++ui;
        if constexpr (ALIGN_EPI) { if (wr == 1) PG8_BAR; }
    }
    PG8_WAIT_V(0);
    if constexpr (!ALIGN_EPI) { if (wr == 0) PG8_BAR; }
    PG8_BAR;
    if constexpr (Epi::AFTER_DRAIN) { E.fused(acc, cur, wr, wc, fr, fq, lds, wid, lane); S.done(cur); }
#undef PG8_SA
#undef PG8_SB
#undef PG8_STAGE
#undef PG8_LDA
#undef PG8_LDB
#undef PG8_MMA
#undef PG8_WAIT_V
#undef PG8_WAIT_L
#undef PG8_BAR
#undef PG8_SCHED
}
}

constexpr int NWAVES = 8;
#ifndef MK_N_LAUNCHES
#define MK_N_LAUNCHES 1
#endif
constexpr int N_PHASES = 12;
constexpr int DM = 2048, TSEQ = 2048, NBATCH = 4, MP = 8192, NSAMP = 128, MV = 8320, MPAD = 8448, FF = 5504, NQKV = 1536, NRW = 3360, NRWP = 3584, NIN = 5120, KL = 384, NL = 3072;
using pg8::sigmoid_f;
constexpr float QSCALE = 0.125f * 1.4426950408889634f, LOG2E = 1.4426950408889634f;
constexpr size_t O_YP = 0, O_YS = 16777216, O_PSHIFT = 17039360, O_PWKV = 17052800, O_PKWIN = 17314944, O_PVWIN = 17446016, O_SSHIFT = 17577088, O_SWKV = 18007168, O_SKWIN = 26395776, O_SVWIN = 30590080, O_END = 34784384;
constexpr size_t MiB = 1u << 20;
constexpr size_t WS_CTL = 0, CTL_ZERO_BYTES = 1 * MiB;
constexpr size_t WS_W1T = 1 * MiB, WS_W2T = 44 * MiB, WS_WINT = 66 * MiB, WS_WOUTT = 86 * MiB, WS_WLT = 94 * MiB, WS_XB = 97 * MiB, WS_H = 130 * MiB, WS_PRW = 219 * MiB, WS_QKV = 335 * MiB, WS_OMIX = 360 * MiB, WS_END = 393 * MiB;
constexpr size_t WS_LWW = WS_H, WS_LWA = WS_H + (size_t)MPAD * 1024 * 4, WS_LWG = WS_H + (size_t)MPAD * 1024 * 8, WS_ALORA = WS_H + (size_t)MPAD * 1024 * 10;
constexpr size_t WS_ORAW = WS_XB;
static_assert(WS_ALORA + (size_t)MPAD * KL * 2 <= WS_H + (size_t)MPAD * FF * 2 && WS_H + (size_t)MPAD * FF * 2 <= WS_PRW && WS_PRW + (size_t)MPAD * NRWP * 4 <= WS_QKV && WS_QKV + (size_t)MPAD * NQKV * 2 <= WS_OMIX && WS_OMIX + (size_t)MPAD * DM * 2 <= WS_END, "ws map");
static_assert(WS_W1T + (size_t)2 * FF * DM * 2 <= WS_W2T && WS_W2T + (size_t)FF * DM * 2 <= WS_WINT && WS_WINT + (size_t)NIN * DM * 2 <= WS_WOUTT && WS_WOUTT + (size_t)DM * DM * 2 <= WS_WLT && WS_WLT + (size_t)NL * KL * 2 <= WS_XB && WS_XB + (size_t)MPAD * DM * 2 <= WS_H, "ws map 2");
constexpr int CW_BAR = 4096, CW_SS = 16384, SS_STRIDE = 16384, CW_ZROW = 131072;
constexpr int RING_BYTES = 131072, LDSCTL_OFF = RING_BYTES, MISC_OFF = LDSCTL_OFF + 320, LDS_BYTES = 147456;

#define GAS __attribute__((address_space(1)))
#define LAS __attribute__((address_space(3)))
typedef unsigned short bf16;
typedef unsigned v4u __attribute__((ext_vector_type(4)));
typedef unsigned v2u __attribute__((ext_vector_type(2)));
typedef float f32x4 __attribute__((ext_vector_type(4)));
typedef short bf16x8 __attribute__((ext_vector_type(8)));
typedef short s16x4 __attribute__((ext_vector_type(4)));
#define LDS_WAIT() asm volatile("s_waitcnt lgkmcnt(0)" ::: "memory")
#define VM_WAIT() asm volatile("s_waitcnt vmcnt(0)" ::: "memory")
__device__ __forceinline__ unsigned f2bf(float f) { unsigned u = __builtin_bit_cast(unsigned, f); return (u + 0x7fffu + ((u >> 16) & 1u)) >> 16; }
__device__ __forceinline__ unsigned pk2(float lo, float hi) { return f2bf(lo) | (f2bf(hi) << 16); }
__device__ __forceinline__ float bf2f(unsigned short b) { return __builtin_bit_cast(float, (unsigned)b << 16); }
__device__ __forceinline__ float bflo(unsigned w) { return __builtin_bit_cast(float, w << 16); }
__device__ __forceinline__ float bfhi(unsigned w) { return __builtin_bit_cast(float, w & 0xffff0000u); }
#define XB_TMO      128
#define XB_XCNT(j)  (256  + 64 * (j))
#define XB_XSUB(j)  (1280 + 64 * (j))
#define XB_XGEN(j)  (2304 + 64 * (j))
#define XB_TOP      3328
#define XB_TOPGEN   3392
#define XCD_BAR_WORDS 3456
#define XB_SPIN_CAP (1u << 18)

__device__ __forceinline__ unsigned xb_ld(unsigned* p)              { return __hip_atomic_load(p, __ATOMIC_RELAXED, __HIP_MEMORY_SCOPE_AGENT); }
__device__ __forceinline__ unsigned xb_add(unsigned* p, unsigned v) { return __hip_atomic_fetch_add(p, v, __ATOMIC_RELAXED, __HIP_MEMORY_SCOPE_AGENT); }
__device__ __forceinline__ unsigned xb_xcc_id() { return (unsigned)__builtin_amdgcn_s_getreg((3 << 11) | 20) & 0xFu; }
#define XB_SPIN(cond, bar) do { unsigned _sp = 0; while (cond) { __builtin_amdgcn_s_sleep(1); \
    if ((++_sp & 255u) == 0u) { if (xb_ld(&(bar)[XB_TMO])) break; if (_sp > XB_SPIN_CAP) { atomicAdd(&(bar)[XB_TMO], 1u); break; } } } } while (0)

struct XcdBarrier {
    unsigned* bar; unsigned x;
    volatile LAS unsigned* st;
};

__device__ __forceinline__ XcdBarrier xcd_barrier_post(unsigned* bar, volatile LAS unsigned* st) {
    XcdBarrier b; b.bar = bar; b.x = xb_xcc_id(); b.st = st;
    if (threadIdx.x == 0) (void)xb_add(&bar[XB_XCNT(b.x)], 1u);
    return b;
}
__device__ __forceinline__ void xcd_barrier_complete(unsigned* bar, unsigned x, unsigned& nloc, unsigned& nx) {
    const unsigned G = gridDim.x * gridDim.y * gridDim.z;
    unsigned sum, cnt, mine, sp = 0u;
    for (;;) {
        sum = 0u; cnt = 0u; mine = 0u;
#pragma unroll
        for (unsigned j = 0; j < 16; ++j) { const unsigned c = xb_ld(&bar[XB_XCNT(j)]); sum += c; cnt += (c > 0u) ? 1u : 0u; mine = (j == x) ? c : mine; }
        if (sum == G) break;
        __builtin_amdgcn_s_sleep(1);
        if ((++sp & 255u) == 0u) { if (xb_ld(&bar[XB_TMO])) break; if (sp > XB_SPIN_CAP) { atomicAdd(&bar[XB_TMO], 1u); break; } }
    }
    nloc = mine > 0u ? mine : 1u; nx = cnt > 0u ? cnt : 1u;
}

__device__ __forceinline__ void xcd_barrier(const XcdBarrier& b) {
    asm volatile("s_waitcnt vmcnt(0)" ::: "memory");
    __syncthreads();
    if (threadIdx.x == 0) {
        unsigned* bar = b.bar;
        __builtin_amdgcn_s_waitcnt(0);
        unsigned nloc = b.st[0], nx = b.st[1];
        if (nloc == 0u) { xcd_barrier_complete(bar, b.x, nloc, nx); b.st[0] = nloc; b.st[1] = nx; }
        const unsigned old = xb_add(&bar[XB_XSUB(b.x)], 1u);
        const unsigned gen = old / nloc;
        if (old + 1u == (gen + 1u) * nloc) {
            __builtin_amdgcn_fence(__ATOMIC_RELEASE, "agent");
            asm volatile("s_waitcnt vmcnt(0)" ::: "memory");
            const unsigned og = xb_add(&bar[XB_TOP], 1u);
            const unsigned tg = og / nx;
            if (og + 1u == (tg + 1u) * nx) xb_add(&bar[XB_TOPGEN], 1u);
            else XB_SPIN(xb_ld(&bar[XB_TOPGEN]) == tg, bar);
            __builtin_amdgcn_fence(__ATOMIC_ACQUIRE, "agent");
            xb_add(&bar[XB_XGEN(b.x)], 1u);
            asm volatile("s_waitcnt vmcnt(0)" ::: "memory");
        } else {
            XB_SPIN(xb_ld(&bar[XB_XGEN(b.x)]) == gen, bar);
            __builtin_amdgcn_fence(__ATOMIC_ACQUIRE, "agent");
            asm volatile("s_waitcnt vmcnt(0)" ::: "memory");
        }
    }
    __syncthreads();
}
struct Args { const float* in[30]; float* out; unsigned char* ws; int ph_lo, ph_hi; };
enum { I_XP = 0, I_XS, I_SSHIFT, I_SWKV, I_CK, I_CV, I_N1, I_W1G, I_W1U, I_W1D, I_NMIX, I_WIN, I_MU, I_DUP, I_DBASE, I_IUP, I_IBASE, I_GUP, I_KK, I_KA, I_RK, I_LNG, I_LNB, I_SINK, I_WOUT, I_N2, I_W2G, I_W2U, I_W2D, I_NF };

struct Ctx { LAS unsigned char* lds; int tid, lane, wave, gw, ngw; };

template <int CTRL> __device__ __forceinline__ float dpp_f(float x) { return __builtin_bit_cast(float, __builtin_amdgcn_mov_dpp(__builtin_bit_cast(int, x), CTRL, 0xf, 0xf, true)); }
__device__ __forceinline__ float red8(float x) { x += dpp_f<0xB1>(x); x += dpp_f<0x4E>(x); x += dpp_f<0x141>(x); return x; }
__device__ __forceinline__ float red16(float x) { x = red8(x); x += dpp_f<0x140>(x); return x; }
__device__ __forceinline__ float wave_sum(float v) {
#pragma unroll
    for (int o = 1; o < 64; o <<= 1) v += __shfl_xor(v, o);
    return v;
}
__device__ __forceinline__ float wave_max(float v) {
#pragma unroll
    for (int o = 1; o < 64; o <<= 1) v = fmaxf(v, __shfl_xor(v, o));
    return v;
}
__device__ __forceinline__ float dot4(f32x4 a, f32x4 b) { return (a[0] * b[0] + a[1] * b[1]) + (a[2] * b[2] + a[3] * b[3]); }

template <int MODE> __device__ __forceinline__ void tr_item(const float* W, int K, int N, const float* gain, bf16* WT, LAS float* scr, int item, int lane) {
    const int nblk = N / 32, kb = item / nblk, nb = item % nblk, k0 = 64 * kb, n0 = 32 * nb;
#pragma unroll 8
    for (int i = 0; i < 32; ++i) { const int kk = 2 * i + (lane >> 5); float v = W[(size_t)(k0 + kk) * N + n0 + (lane & 31)]; if (gain) v *= gain[k0 + kk]; scr[kk * 33 + (lane & 31)] = v; }
    LDS_WAIT(); asm volatile("" ::: "memory");
    const int c = lane & 7;
    const int r0 = MODE == 0 ? n0 : (256 * (n0 >> 7) + (n0 & 127) + (MODE == 2 ? 128 : 0));
#pragma unroll
    for (int j = 0; j < 4; ++j) { const int n = (lane >> 3) + 8 * j; const LAS float* s = scr + (8 * c) * 33 + n;
        v4u o; o.x = pk2(s[0 * 33], s[1 * 33]); o.y = pk2(s[2 * 33], s[3 * 33]); o.z = pk2(s[4 * 33], s[5 * 33]); o.w = pk2(s[6 * 33], s[7 * 33]);
        *(v4u*)(WT + (size_t)(r0 + n) * K + k0 + 8 * c) = o; }
    LDS_WAIT(); asm volatile("" ::: "memory");
}
__device__ __forceinline__ void convert_ffn(const Ctx& C, const float* Wg, const float* Wu, const float* Wd, const float* gain, bf16* W1T, bf16* W2T) {
    LAS float* scr = (LAS float*)(C.lds + C.wave * 16384);
    constexpr int I_G = (DM / 64) * (FF / 32), I_D = (FF / 64) * (DM / 32);
    for (int it = C.gw; it < 2 * I_G + I_D; it += C.ngw) {
        int r = it;
        if (r < I_G) { tr_item<1>(Wg, DM, FF, gain, W1T, scr, r, C.lane); continue; } r -= I_G;
        if (r < I_G) { tr_item<2>(Wu, DM, FF, gain, W1T, scr, r, C.lane); continue; } r -= I_G;
        tr_item<0>(Wd, FF, DM, nullptr, W2T, scr, r, C.lane);
    }
}

__device__ __forceinline__ void phase_prologue(const Ctx& C, const Args& a) {
    unsigned char* ws = a.ws;
    convert_ffn(C, a.in[I_W1G], a.in[I_W1U], a.in[I_W1D], a.in[I_N1], (bf16*)(ws + WS_W1T), (bf16*)(ws + WS_W2T));
    {
        LAS float* scr = (LAS float*)(C.lds + C.wave * 16384);
        constexpr int I_IN = (DM / 64) * (4896 / 32), I_OUT = (DM / 64) * (DM / 32);
        for (int it = C.gw; it < I_IN + I_OUT; it += C.ngw) {
            if (it < I_IN) tr_item<0>(a.in[I_WIN], DM, 4896, a.in[I_NMIX], (bf16*)(ws + WS_WINT), scr, it, C.lane);
            else tr_item<0>(a.in[I_WOUT], DM, DM, nullptr, (bf16*)(ws + WS_WOUTT), scr, it - I_IN, C.lane);
        }
    }
    {
        v4u* z = (v4u*)((bf16*)(ws + WS_WINT) + (size_t)4896 * DM);
        for (int i = C.gw * 64 + C.lane; i < 224 * DM / 8; i += C.ngw * 64) z[i] = (v4u){0u, 0u, 0u, 0u};
    }
    {
        bf16* WL = (bf16*)(ws + WS_WLT);
        for (int e = C.gw * 64 + C.lane; e < KL * NL; e += C.ngw * 64) { const int k = e / NL, n = e % NL; float v = 0.f;
            if (n < 1024) { if (k < 64) v = a.in[I_DUP][k * 1024 + n]; }
            else if (n < 2048) { if (k >= 64 && k < 128) v = a.in[I_IUP][(k - 64) * 1024 + (n - 1024)]; }
            else { if (k >= 128 && k < 288) v = a.in[I_GUP][(k - 128) * 1024 + (n - 2048)]; }
            WL[(size_t)n * KL + k] = (bf16)f2bf(v); }
    }
    {
        bf16* XB = (bf16*)(ws + WS_XB); float* ss1 = (float*)(ws + WS_CTL) + CW_SS;
        for (int m = C.gw; m < MPAD; m += C.ngw) {
            const float* xr = m < MP ? a.in[I_XP] + (size_t)m * DM : a.in[I_XS] + (size_t)(m - MP) * DM;
            float s = 0.f;
#pragma unroll
            for (int j = 0; j < 8; ++j) { f32x4 v = (f32x4){0.f, 0.f, 0.f, 0.f}; if (m < MV) v = *((const f32x4*)xr + C.lane + 64 * j);
                s += dot4(v, v); v2u o; o.x = pk2(v[0], v[1]); o.y = pk2(v[2], v[3]); *((v2u*)(XB + (size_t)m * DM) + C.lane + 64 * j) = o; }
            s = wave_sum(s); if (C.lane == 0) ss1[m] = s;
        }
    }
}

struct Ops { f32x4 na, w, b, kp, r, v; };
__device__ __forceinline__ f32x4 sig4(f32x4 x) { return (f32x4){sigmoid_f(x[0]), sigmoid_f(x[1]), sigmoid_f(x[2]), sigmoid_f(x[3])}; }
__device__ __forceinline__ f32x4 decay4(f32x4 x) { const f32x4 s = sig4(x); return (f32x4){__builtin_amdgcn_exp2f(-0.8750387749f * s[0]), __builtin_amdgcn_exp2f(-0.8750387749f * s[1]), __builtin_amdgcn_exp2f(-0.8750387749f * s[2]), __builtin_amdgcn_exp2f(-0.8750387749f * s[3])}; }
struct RwConst { const float* mu; const float* k_k; const float* k_a; };
template <bool WITH_W> __device__ __forceinline__ void prep_ops(Ops& o, const float* prow, const float* pprev, const float* wrow, const float* arow, const RwConst& rc, int hk) {
    const f32x4 pr = *(const f32x4*)(prow + hk), pk = *(const f32x4*)(prow + 1024 + hk), pv = *(const f32x4*)(prow + 2048 + hk);
    const f32x4 qr = *(const f32x4*)(pprev + hk), qk = *(const f32x4*)(pprev + 1024 + hk), qv = *(const f32x4*)(pprev + 2048 + hk);
    const f32x4 mr = *(const f32x4*)(rc.mu + hk), mk = *(const f32x4*)(rc.mu + 1024 + hk), mv = *(const f32x4*)(rc.mu + 2048 + hk);
    const f32x4 a4 = sig4(*(const f32x4*)(arow + hk)), kk4 = *(const f32x4*)(rc.k_k + hk), ka4 = *(const f32x4*)(rc.k_a + hk);
    const f32x4 ur = pr + mr * (qr - pr), uk = pk + mk * (qk - pk), uv = pv + mv * (qv - pv);
    const f32x4 kk = uk * kk4;
    const float n2 = red16(dot4(kk, kk));
    const float inv = 1.0f / fmaxf(sqrtf(n2), 1e-12f);
    const f32x4 kkn = kk * inv;
    o.na = -kkn; o.b = kkn * a4; o.kp = uk * (1.0f + (a4 - 1.0f) * ka4); o.r = ur; o.v = uv;
    if (WITH_W) o.w = decay4(*(const f32x4*)(wrow + hk)); else o.w = (f32x4){0.f, 0.f, 0.f, 0.f};
}

typedef short v4i16_t __attribute__((ext_vector_type(4)));
constexpr int AT_STRIDE = 160, AT_ROWS = 272, AT_KOFF = 0, AT_VOFF = AT_ROWS * AT_STRIDE, AT_END = 2 * AT_ROWS * AT_STRIDE;
__device__ __forceinline__ void attn_prompt_unit(const Ctx& C, const Args& a, int unit) {
    const bf16* QKV = (const bf16*)(a.ws + WS_QKV); bf16* OMIX = (bf16*)(a.ws + WS_OMIX);
    const int b = unit >> 6, nb = (unit >> 2) & 15, c = unit & 3;
    const int m0 = b * TSEQ + nb * 128;
    LAS unsigned char* Kt = C.lds + AT_KOFF; LAS unsigned char* Vt = C.lds + AT_VOFF;
    __syncthreads();
    for (int i = C.tid; i < 2 * AT_ROWS * 8; i += 512) { const int which = i / (AT_ROWS * 8), r = (i % (AT_ROWS * 8)) >> 3, ch = i & 7;
        v4u v = (v4u){0u, 0u, 0u, 0u};
        if (r < 256 && (nb > 0 || r >= 128)) v = *(const v4u*)(QKV + (size_t)(m0 - 128 + r) * NQKV + 1024 + which * 256 + c * 64 + ch * 8);
        *(LAS v4u*)((which ? Vt : Kt) + r * AT_STRIDE + ch * 16) = v; }
    __syncthreads();
    const int w = C.wave, fr = C.lane & 15, fq = C.lane >> 4;
#pragma unroll 1
    for (int hq = 0; hq < 4; ++hq) { const int h = 4 * c + hq;
        const float slope2 = __builtin_amdgcn_exp2f(-0.5f * (float)(h + 1)) * LOG2E, sink2 = a.in[I_SINK][h] * LOG2E;
        const bf16* qp = QKV + (size_t)(m0 + 16 * w + fr) * NQKV + h * 64 + 8 * fq;
        const bf16x8 q0 = *(const bf16x8*)qp, q1 = *(const bf16x8*)(qp + 32);
        f32x4 s[10];
#pragma unroll
        for (int kt = 0; kt < 10; ++kt) { const LAS unsigned char* kp = Kt + (16 * (w + kt) + fr) * AT_STRIDE + 16 * fq;
            const bf16x8 k0 = *(const LAS bf16x8*)kp, k1 = *(const LAS bf16x8*)(kp + 64);
            f32x4 acc = (f32x4){0.f, 0.f, 0.f, 0.f};
            acc = __builtin_amdgcn_mfma_f32_16x16x32_bf16(k0, q0, acc, 0, 0, 0); acc = __builtin_amdgcn_mfma_f32_16x16x32_bf16(k1, q1, acc, 0, 0, 0);
            s[kt] = acc; }
        const int qi = 16 * w + fr; float mx = sink2;
#pragma unroll
        for (int kt = 0; kt < 10; ++kt)
#pragma unroll
            for (int r = 0; r < 4; ++r) { const int kj = 16 * (w + kt) + 4 * fq + r, dist = 128 + qi - kj; const bool ok = dist >= 0 && dist < 128 && (nb > 0 || kj >= 128);
                const float v = ok ? s[kt][r] - slope2 * (float)dist : -1e30f; s[kt][r] = v; mx = fmaxf(mx, v); }
        mx = fmaxf(mx, __shfl_xor(mx, 16)); mx = fmaxf(mx, __shfl_xor(mx, 32));
        float sum = 0.f;
#pragma unroll
        for (int kt = 0; kt < 10; ++kt)
#pragma unroll
            for (int r = 0; r < 4; ++r) { const float p = __builtin_amdgcn_exp2f(s[kt][r] - mx); s[kt][r] = p; sum += p; }
        sum += __shfl_xor(sum, 16); sum += __shfl_xor(sum, 32);
        const float inv = 1.0f / (sum + __builtin_amdgcn_exp2f(sink2 - mx));
        f32x4 o[4];
#pragma unroll
        for (int dt = 0; dt < 4; ++dt) o[dt] = (f32x4){0.f, 0.f, 0.f, 0.f};
#pragma unroll
        for (int st = 0; st < 5; ++st) {
            union { bf16x8 v; unsigned u[4]; } pb;
            pb.u[0] = pk2(s[2 * st][0], s[2 * st][1]); pb.u[1] = pk2(s[2 * st][2], s[2 * st][3]); pb.u[2] = pk2(s[2 * st + 1][0], s[2 * st + 1][1]); pb.u[3] = pk2(s[2 * st + 1][2], s[2 * st + 1][3]);
#pragma unroll
            for (int dt = 0; dt < 4; ++dt) {
                const LAS unsigned char* vp = Vt + (16 * (w + 2 * st) + 4 * fq + (fr >> 2)) * AT_STRIDE + (16 * dt + 4 * (fr & 3)) * 2;
                const v4i16_t t0 = __builtin_amdgcn_ds_read_tr16_b64_v4i16((LAS v4i16_t*)vp), t1 = __builtin_amdgcn_ds_read_tr16_b64_v4i16((LAS v4i16_t*)(vp + 16 * AT_STRIDE));
                bf16x8 va; va[0] = t0[0]; va[1] = t0[1]; va[2] = t0[2]; va[3] = t0[3]; va[4] = t1[0]; va[5] = t1[1]; va[6] = t1[2]; va[7] = t1[3];
                o[dt] = __builtin_amdgcn_mfma_f32_16x16x32_bf16(va, pb.v, o[dt], 0, 0, 0); } }
        bf16* op = OMIX + (size_t)(m0 + 16 * w + fr) * DM + 1024 + h * 64 + 4 * fq;
#pragma unroll
        for (int dt = 0; dt < 4; ++dt) { v2u ov; ov.x = pk2(o[dt][0] * inv, o[dt][1] * inv); ov.y = pk2(o[dt][2] * inv, o[dt][3] * inv); *(v2u*)(op + 16 * dt) = ov; }
    }
}
__device__ __forceinline__ void attn_sample_item(const Ctx& C, const Args& a, int item, LAS float* scr  ) {
    const bf16* QKV = (const bf16*)(a.ws + WS_QKV); bf16* OMIX = (bf16*)(a.ws + WS_OMIX);
    const int b = item >> 2, c = item & 3, lane = C.lane; const int mrow = MP + b;
    LAS float* qs = scr; LAS float* ps = scr + 256;
#pragma unroll
    for (int hq = 0; hq < 4; ++hq) qs[hq * 64 + lane] = bf2f(QKV[(size_t)mrow * NQKV + (4 * c + hq) * 64 + lane]);
    LDS_WAIT(); asm volatile("" ::: "memory");
    const float* ck = a.in[I_CK] + ((size_t)b * 128 * 4 + c) * 64; const float* cv = a.in[I_CV] + ((size_t)b * 128 * 4 + c) * 64;
    float* kw = a.out + O_SKWIN + ((size_t)b * 128 * 4 + c) * 64; float* vw = a.out + O_SVWIN + ((size_t)b * 128 * 4 + c) * 64;
#pragma unroll 1
    for (int jj = 0; jj < 3; ++jj) { const int j = jj < 2 ? lane + 64 * jj : 128;
        float d0 = 0.f, d1 = 0.f, d2 = 0.f, d3 = 0.f;
#pragma unroll 4
        for (int d4 = 0; d4 < 16; ++d4) { f32x4 kv;
            if (j < 128) { kv = *(const f32x4*)(ck + (size_t)j * 256 + 4 * d4); if (j >= 1) *(f32x4*)(kw + (size_t)(j - 1) * 256 + 4 * d4) = kv; }
            else { const v2u t = *(const v2u*)(QKV + (size_t)mrow * NQKV + 1024 + c * 64 + 4 * d4); kv = (f32x4){bflo(t.x), bfhi(t.x), bflo(t.y), bfhi(t.y)}; }
            d0 += dot4(kv, *(const LAS f32x4*)(qs + 0 * 64 + 4 * d4)); d1 += dot4(kv, *(const LAS f32x4*)(qs + 1 * 64 + 4 * d4));
            d2 += dot4(kv, *(const LAS f32x4*)(qs + 2 * 64 + 4 * d4)); d3 += dot4(kv, *(const LAS f32x4*)(qs + 3 * 64 + 4 * d4)); }
        if (jj < 2 || lane == 0) { ps[0 * 132 + j] = d0; ps[1 * 132 + j] = d1; ps[2 * 132 + j] = d2; ps[3 * 132 + j] = d3; } }
    LDS_WAIT(); asm volatile("" ::: "memory");
#pragma unroll 1
    for (int hq = 0; hq < 4; ++hq) { const int h = 4 * c + hq;
        const float slope2 = __builtin_amdgcn_exp2f(-0.5f * (float)(h + 1)) * LOG2E, sink2 = a.in[I_SINK][h] * LOG2E;
        const float v0 = lane >= 1 ? ps[hq * 132 + lane] - slope2 * (float)(128 - lane) : -1e30f;
        const float v1 = ps[hq * 132 + 64 + lane] - slope2 * (float)(64 - lane);
        const float v2 = ps[hq * 132 + 128];
        const float mx = wave_max(fmaxf(fmaxf(v0, v1), fmaxf(v2, sink2)));
        const float p0 = __builtin_amdgcn_exp2f(v0 - mx), p1 = __builtin_amdgcn_exp2f(v1 - mx), p2 = __builtin_amdgcn_exp2f(v2 - mx);
        const float tot = wave_sum(p0 + p1) + p2 + __builtin_amdgcn_exp2f(sink2 - mx); const float inv = 1.0f / tot;
        LDS_WAIT(); asm volatile("" ::: "memory");
        ps[hq * 132 + lane] = p0 * inv; ps[hq * 132 + 64 + lane] = p1 * inv; if (lane == 0) ps[hq * 132 + 128] = p2 * inv; }
    LDS_WAIT(); asm volatile("" ::: "memory");
    float o0 = 0.f, o1 = 0.f, o2 = 0.f, o3 = 0.f;
#pragma unroll 4
    for (int j = 0; j < 128; ++j) { const float vv = cv[(size_t)j * 256 + lane]; if (j >= 1) vw[(size_t)(j - 1) * 256 + lane] = vv;
        o0 += ps[0 * 132 + j] * vv; o1 += ps[1 * 132 + j] * vv; o2 += ps[2 * 132 + j] * vv; o3 += ps[3 * 132 + j] * vv; }
    { const float vv = bf2f(QKV[(size_t)mrow * NQKV + 1280 + c * 64 + lane]);
      o0 += ps[0 * 132 + 128] * vv; o1 += ps[1 * 132 + 128] * vv; o2 += ps[2 * 132 + 128] * vv; o3 += ps[3 * 132 + 128] * vv; }
    bf16* op = OMIX + (size_t)mrow * DM + 1024 + (4 * c) * 64 + lane;
    op[0] = (bf16)f2bf(o0); op[64] = (bf16)f2bf(o1); op[128] = (bf16)f2bf(o2); op[192] = (bf16)f2bf(o3);
    LDS_WAIT(); asm volatile("" ::: "memory");
}
__device__ __forceinline__ void phase_mixprep(const Ctx& C, const Args& a) {
    unsigned char* ws = a.ws;
    const float* PRW = (const float*)(ws + WS_PRW); const float* ZROW = (const float*)(ws + WS_CTL) + CW_ZROW;
    for (int unit = blockIdx.x; unit < 256; unit += gridDim.x) attn_prompt_unit(C, a, unit);
    __syncthreads();
    for (int it = C.gw; it < NSAMP * 4; it += C.ngw) attn_sample_item(C, a, it, (LAS float*)(C.lds + C.wave * 16384));
    { bf16* AL = (bf16*)(ws + WS_ALORA); const float* mu = a.in[I_MU] + 3072;
      for (int m = C.gw; m < MPAD; m += C.ngw) {
        const float* prow = PRW + (size_t)m * NRWP + 3072;
        const float* pprev = m < MP ? ((m & 2047) ? prow - NRWP : ZROW) : (m < MV ? a.in[I_SSHIFT] + (size_t)(m - MP) * NRW + 3072 : ZROW);
#pragma unroll
        for (int jj = 0; jj < 6; ++jj) { const int j = C.lane + 64 * jj; float v = 0.f;
            if (j < 288 && m < MV) { const float p = prow[j]; const float u = p + mu[j] * (pprev[j] - p);
                v = j < 64 ? (2.0f * sigmoid_f(2.0f * u) - 1.0f) : (j < 128 ? u : sigmoid_f(u)); }
            AL[(size_t)m * KL + j] = (bf16)f2bf(v); } } }
    for (int r = C.gw; r < NBATCH + NSAMP; r += C.ngw) {
        const float* src = PRW + (size_t)(r < NBATCH ? r * TSEQ + TSEQ - 1 : MP + (r - NBATCH)) * NRWP;
        float* dst = r < NBATCH ? a.out + O_PSHIFT + (size_t)r * NRW : a.out + O_SSHIFT + (size_t)(r - NBATCH) * NRW;
        for (int j = C.lane; j < NRW / 4; j += 64) *((f32x4*)dst + j) = *((const f32x4*)src + j); }
    convert_ffn(C, a.in[I_W2G], a.in[I_W2U], a.in[I_W2D], a.in[I_N2], (bf16*)(ws + WS_W1T), (bf16*)(ws + WS_W2T));
}

constexpr int SC_CH = 16, SC_NCH = TSEQ / SC_CH, SC_OPB = SC_CH * 6 * 64;
struct StRaw { f32x4 pr, pk, pv, qr, qk, qv, w, a; };
__device__ __forceinline__ void phase_scan(const Ctx& C, const Args& a) {
    unsigned char* ws = a.ws;
    const float* PRW = (const float*)(ws + WS_PRW); const float* ZROW = (const float*)(ws + WS_CTL) + CW_ZROW;
    const float* LWW = (const float*)(ws + WS_LWW); const float* LWA = (const float*)(ws + WS_LWA); float* ORAW = (float*)(ws + WS_ORAW);
    const RwConst rc{a.in[I_MU], a.in[I_KK], a.in[I_KA]};
    LAS float* opb = (LAS float*)C.lds; LAS float* obf = (LAS float*)(C.lds + 2 * SC_OPB * 4);
    const int wave = C.wave, lane = C.lane;
    for (int item = blockIdx.x; item < 256; item += gridDim.x) {
        const int chain = item >> 2, qr = item & 3, b = chain >> 4, h = chain & 15;
        const size_t mbase = (size_t)b * TSEQ;
        const int st_t = ((C.tid - 128) >> 4) & 15, st_kg = lane & 15, hk = h * 64 + 4 * st_kg;
        const f32x4 mr = *(const f32x4*)(rc.mu + hk), mk = *(const f32x4*)(rc.mu + 1024 + hk), mv = *(const f32x4*)(rc.mu + 2048 + hk), kk4 = *(const f32x4*)(rc.k_k + hk), ka4 = *(const f32x4*)(rc.k_a + hk);
        StRaw raw;
        auto st_load = [&](int c) { const int t = c * SC_CH + st_t; const float* prow = PRW + (mbase + t) * NRWP; const float* pp = t ? prow - NRWP : ZROW;
            raw.pr = *(const f32x4*)(prow + hk); raw.pk = *(const f32x4*)(prow + 1024 + hk); raw.pv = *(const f32x4*)(prow + 2048 + hk);
            raw.qr = *(const f32x4*)(pp + hk); raw.qk = *(const f32x4*)(pp + 1024 + hk); raw.qv = *(const f32x4*)(pp + 2048 + hk);
            raw.w = *(const f32x4*)(LWW + (mbase + t) * 1024 + hk); raw.a = *(const f32x4*)(LWA + (mbase + t) * 1024 + hk); };
        auto st_emit = [&](int c) { LAS float* ob = opb + (c & 1) * SC_OPB + st_t * 384 + 4 * st_kg;
            const f32x4 ur = raw.pr + mr * (raw.qr - raw.pr), uk = raw.pk + mk * (raw.qk - raw.pk), uv = raw.pv + mv * (raw.qv - raw.pv);
            const f32x4 kk = uk * kk4; const float n2 = red16(dot4(kk, kk)); const float inv = 1.0f / fmaxf(sqrtf(n2), 1e-12f); const f32x4 kkn = kk * inv;
            const f32x4 aa = sig4(raw.a);
            *(LAS f32x4*)(ob + 0 * 64) = -kkn; *(LAS f32x4*)(ob + 1 * 64) = decay4(raw.w); *(LAS f32x4*)(ob + 2 * 64) = kkn * aa;
            *(LAS f32x4*)(ob + 3 * 64) = uk * (1.0f + (aa - 1.0f) * ka4); *(LAS f32x4*)(ob + 4 * 64) = ur; *(LAS f32x4*)(ob + 5 * 64) = uv; };
        const int row_l = lane >> 3, kq = lane & 7, vrow = 16 * qr + 8 * wave + row_l;
        float S[8];
#pragma unroll
        for (int j = 0; j < 8; ++j) S[j] = 0.f;
        __syncthreads();
        if (wave >= 2 && wave < 6) { st_load(0); st_emit(0); st_load(1); }
        __syncthreads();
#pragma unroll 1
        for (int c = 0; c < SC_NCH; ++c) {
            if (wave < 2) {
                const LAS float* ob = opb + (c & 1) * SC_OPB + 8 * kq; LAS float* oo = obf + (c & 1) * 256 + 8 * wave + row_l;
#pragma unroll
                for (int t = 0; t < SC_CH; ++t) { const LAS float* p = ob + t * 384;
                    const f32x4 na0 = *(const LAS f32x4*)(p), na1 = *(const LAS f32x4*)(p + 4), w0 = *(const LAS f32x4*)(p + 64), w1 = *(const LAS f32x4*)(p + 68),
                                b0 = *(const LAS f32x4*)(p + 128), b1 = *(const LAS f32x4*)(p + 132), k0 = *(const LAS f32x4*)(p + 192), k1 = *(const LAS f32x4*)(p + 196),
                                r0 = *(const LAS f32x4*)(p + 256), r1 = *(const LAS f32x4*)(p + 260);
                    const float vv = opb[(c & 1) * SC_OPB + t * 384 + 320 + vrow];
                    float d0 = S[0] * na0[0] + S[1] * na0[1], d1 = S[2] * na0[2] + S[3] * na0[3]; d0 += S[4] * na1[0] + S[5] * na1[1]; d1 += S[6] * na1[2] + S[7] * na1[3];
                    const float sa = red8(d0 + d1);
#pragma unroll
                    for (int j = 0; j < 4; ++j) { S[j] = S[j] * w0[j] + (sa * b0[j] + vv * k0[j]); S[4 + j] = S[4 + j] * w1[j] + (sa * b1[j] + vv * k1[j]); }
                    float e0 = S[0] * r0[0] + S[1] * r0[1], e1 = S[2] * r0[2] + S[3] * r0[3]; e0 += S[4] * r1[0] + S[5] * r1[1]; e1 += S[6] * r1[2] + S[7] * r1[3];
                    const float ov = red8(e0 + e1);
                    if (kq == 0) oo[t * 16] = ov; }
            } else if (wave < 6) {
                if (c + 1 < SC_NCH) { st_emit(c + 1); if (c + 2 < SC_NCH) st_load(c + 2); }
            } else if (wave == 6) {
                if (c >= 1) { const int t = (c - 1) * SC_CH + (lane >> 2); const f32x4 v = *(const LAS f32x4*)(obf + ((c - 1) & 1) * 256 + (lane >> 2) * 16 + 4 * (lane & 3));
                    *(f32x4*)(ORAW + (mbase + t) * 1024 + h * 64 + 16 * qr + 4 * (lane & 3)) = v; }
            }
            __syncthreads();
        }
        if (wave == 6) { const int c = SC_NCH; const int t = (c - 1) * SC_CH + (lane >> 2); const f32x4 v = *(const LAS f32x4*)(obf + ((c - 1) & 1) * 256 + (lane >> 2) * 16 + 4 * (lane & 3));
            *(f32x4*)(ORAW + (mbase + t) * 1024 + h * 64 + 16 * qr + 4 * (lane & 3)) = v; }
        if (wave < 2) { float* sp = a.out + O_PWKV + ((size_t)(b * 16 + h) * 64 + vrow) * 64 + 8 * kq;
            *(f32x4*)sp = (f32x4){S[0], S[1], S[2], S[3]}; *(f32x4*)(sp + 4) = (f32x4){S[4], S[5], S[6], S[7]}; }
    }
    __syncthreads();
    { LAS float* vs = (LAS float*)(C.lds + wave * 16384);
      for (int it = C.gw; it < NSAMP * 16; it += C.ngw) { const int bs = it >> 4, hs = it & 15, kg = lane & 15, v_l = lane >> 4, hk = hs * 64 + 4 * kg; const size_t m = MP + bs;
        Ops o; prep_ops<true>(o, PRW + m * NRWP, a.in[I_SSHIFT] + (size_t)bs * NRW, LWW + m * 1024, LWA + m * 1024, rc, hk);
        if (v_l == 0) *(LAS f32x4*)(vs + 4 * kg) = o.v;
        LDS_WAIT(); asm volatile("" ::: "memory");
        const float* s0 = a.in[I_SWKV] + (size_t)(bs * 16 + hs) * 4096; float* s1 = a.out + O_SWKV + (size_t)(bs * 16 + hs) * 4096;
#pragma unroll 4
        for (int i = 0; i < 16; ++i) { const int row = 4 * i + v_l; const f32x4 S4 = *(const f32x4*)(s0 + row * 64 + 4 * kg);
            const float sa = red16(dot4(S4, o.na)); const float vv = vs[row];
            const f32x4 Sn = S4 * o.w + (o.b * sa + o.kp * vv);
            *(f32x4*)(s1 + row * 64 + 4 * kg) = Sn;
            const float ov = red16(dot4(Sn, o.r));
            if (kg == 0) ORAW[m * 1024 + hs * 64 + row] = ov; }
        LDS_WAIT(); asm volatile("" ::: "memory"); } }
}

__device__ __forceinline__ void phase_post(const Ctx& C, const Args& a) {
    unsigned char* ws = a.ws;
    const float* PRW = (const float*)(ws + WS_PRW); const float* ZROW = (const float*)(ws + WS_CTL) + CW_ZROW; const float* LWA = (const float*)(ws + WS_LWA);
    const bf16* LWG = (const bf16*)(ws + WS_LWG); const float* ORAW = (const float*)(ws + WS_ORAW); bf16* OMIX = (bf16*)(ws + WS_OMIX);
    const RwConst rc{a.in[I_MU], a.in[I_KK], a.in[I_KA]};
    const int kg = C.lane & 15;
    for (int g = C.gw * 4 + (C.lane >> 4); g < MV * 16; g += C.ngw * 4) { const int m = g >> 4, h = g & 15, hk = h * 64 + 4 * kg;
        const float* prow = PRW + (size_t)m * NRWP; const float* pprev = m < MP ? ((m & 2047) ? prow - NRWP : ZROW) : a.in[I_SSHIFT] + (size_t)(m - MP) * NRW;
        Ops o; prep_ops<false>(o, prow, pprev, nullptr, LWA + (size_t)m * 1024, rc, hk);
        const f32x4 rk = *(const f32x4*)(a.in[I_RK] + hk);
        const float sb = red16(dot4(o.r * o.kp, rk));
        const f32x4 o4 = *(const f32x4*)(ORAW + (size_t)m * 1024 + hk);
        const float mean = red16((o4[0] + o4[1]) + (o4[2] + o4[3])) * (1.0f / 64.0f); const f32x4 d = o4 - mean;
        const float var = red16(dot4(d, d)) * (1.0f / 64.0f); const float rstd = 1.0f / sqrtf(var + 64e-5f);
        const f32x4 lg = *(const f32x4*)(a.in[I_LNG] + hk), lb = *(const f32x4*)(a.in[I_LNB] + hk);
        const v2u gw2 = *(const v2u*)(LWG + (size_t)m * 1024 + hk); const f32x4 g4 = (f32x4){bflo(gw2.x), bfhi(gw2.x), bflo(gw2.y), bfhi(gw2.y)};
        const f32x4 res = (d * rstd * lg + lb + o.v * sb) * g4;
        v2u ov; ov.x = pk2(res[0], res[1]); ov.y = pk2(res[2], res[3]); *(v2u*)(OMIX + (size_t)m * DM + hk) = ov; }
}
__device__ __forceinline__ void phase_final(const Ctx& C, const Args& a) {
    const float* ss4 = (const float*)(a.ws + WS_CTL) + CW_SS + 3 * SS_STRIDE; const float* gf = a.in[I_NF];
    for (int m = C.gw; m < MV; m += C.ngw) { const float rs = 1.0f / sqrtf(ss4[m] * (1.0f / 2048.0f) + 1e-6f); f32x4* xr = (f32x4*)(a.out + (size_t)m * DM);
#pragma unroll
        for (int j = 0; j < 8; ++j) { const f32x4 v = xr[C.lane + 64 * j], g = *((const f32x4*)gf + C.lane + 64 * j); xr[C.lane + 64 * j] = v * rs * g; } }
}
__global__ void __launch_bounds__(NWAVES * 64, 2) mk_fwd(Args a_kernarg) {
    const Args& a = *(const Args*)__builtin_amdgcn_kernarg_segment_ptr();
    extern __shared__ __attribute__((aligned(16))) unsigned char lds_raw[];
    Ctx C; C.lds = (LAS unsigned char*)lds_raw; C.tid = threadIdx.x; C.lane = C.tid & 63; C.wave = __builtin_amdgcn_readfirstlane(C.tid >> 6);
    const int G = gridDim.x, bx = blockIdx.x, vcu = (G % 8 == 0) ? (bx % 8) * (G / 8) + bx / 8 : bx;
    C.gw = vcu * NWAVES + C.wave; C.ngw = G * NWAVES;
    volatile LAS unsigned* MISC = (volatile LAS unsigned*)(C.lds + MISC_OFF);
    for (int u = C.tid; u < (LDS_BYTES - LDSCTL_OFF) / 4; u += NWAVES * 64) ((LAS unsigned*)(C.lds + LDSCTL_OFF))[u] = 0u;
    __syncthreads();
    unsigned char* ws = a.ws; unsigned* ctl = (unsigned*)(ws + WS_CTL);
    const int lo = a.ph_lo, hi = a.ph_hi;
    XcdBarrier bar; bar.bar = ctl + CW_BAR; bar.x = 0; bar.st = nullptr;
    if (hi - lo > 1) bar = xcd_barrier_post(ctl + CW_BAR, MISC + 8);
#ifndef PH_MASK
#define PH_MASK 0xFFF
#endif
#define IN(k) (((PH_MASK >> (k)) & 1) && lo <= (k) && (k) < hi)
#define SEAM(k) do { if (IN(k) && IN((k) + 1)) xcd_barrier(bar); } while (0)
    float* ssb = (float*)ctl + CW_SS;
    bf16* XB = (bf16*)(ws + WS_XB); bf16* HB = (bf16*)(ws + WS_H); bf16* OMIX = (bf16*)(ws + WS_OMIX);
    LAS unsigned char* ring = C.lds;

    if (IN(0)) { phase_prologue(C, a); SEAM(0); }
    if (IN(1)) {
        pg8::Gemm g{XB, (const bf16*)(ws + WS_W1T), MPAD, 2 * FF, DM}; pg8::StaticOrder S; S.init(MPAD, 2 * FF, G, bx);
        pg8::EpiSwiglu E{HB, ssb, FF};
        pg8::gemm_phase<pg8::EpiSwiglu, pg8::StaticOrder, true, true>(ring, g, S, E); SEAM(1); }
    if (IN(2)) {
        pg8::Gemm g{HB, (const bf16*)(ws + WS_W2T), MPAD, DM, FF}; pg8::StaticOrder S; S.init(MPAD, DM, G, bx);
        pg8::EpiResid E{a.in[I_XP], a.in[I_XS], a.out, XB, ssb + SS_STRIDE, 0.5f};
        pg8::gemm_phase<pg8::EpiResid, pg8::StaticOrder, true, true>(ring, g, S, E); SEAM(2); }
    if (IN(3)) {
        pg8::Gemm g{XB, (const bf16*)(ws + WS_WINT), MPAD, NIN, DM}; pg8::StaticOrder S; S.init(MPAD, NIN, G, bx);
        pg8::EpiWin E{(bf16*)(ws + WS_QKV), (float*)(ws + WS_PRW), ssb + SS_STRIDE, a.out + O_PKWIN, (long)(O_SKWIN - O_PKWIN), QSCALE};
        pg8::gemm_phase<pg8::EpiWin, pg8::StaticOrder, true, true>(ring, g, S, E); SEAM(3); }
    if (IN(4)) { phase_mixprep(C, a); SEAM(4); }
    if (IN(5)) {
        pg8::Gemm g{(const bf16*)(ws + WS_ALORA), (const bf16*)(ws + WS_WLT), MPAD, NL, KL}; pg8::StaticOrder S; S.init(MPAD, NL, G, bx);
        pg8::EpiLora E{(float*)(ws + WS_LWW), (long)((WS_LWA - WS_LWW) / 4), (bf16*)(ws + WS_LWG), a.in[I_DBASE], (long)(a.in[I_IBASE] - a.in[I_DBASE])};
        pg8::gemm_phase<pg8::EpiLora, pg8::StaticOrder, true, true>(ring, g, S, E); SEAM(5); }
    if (IN(6)) { phase_scan(C, a); SEAM(6); }
    if (IN(7)) { phase_post(C, a); SEAM(7); }
    if (IN(8)) {
        pg8::Gemm g{OMIX, (const bf16*)(ws + WS_WOUTT), MPAD, DM, DM}; pg8::StaticOrder S; S.init(MPAD, DM, G, bx);
        pg8::EpiResid E{a.out, a.out + (size_t)MP * DM, a.out, XB, ssb + 2 * SS_STRIDE, 1.0f};
        pg8::gemm_phase<pg8::EpiResid, pg8::StaticOrder, true, true>(ring, g, S, E); SEAM(8); }
    if (IN(9)) {
        pg8::Gemm g{XB, (const bf16*)(ws + WS_W1T), MPAD, 2 * FF, DM}; pg8::StaticOrder S; S.init(MPAD, 2 * FF, G, bx);
        pg8::EpiSwiglu E{HB, ssb + 2 * SS_STRIDE, FF};
        pg8::gemm_phase<pg8::EpiSwiglu, pg8::StaticOrder, true, true>(ring, g, S, E); SEAM(9); }
    if (IN(10)) {
        pg8::Gemm g{HB, (const bf16*)(ws + WS_W2T), MPAD, DM, FF}; pg8::StaticOrder S; S.init(MPAD, DM, G, bx);
        pg8::EpiResid E{a.out, a.out + (size_t)MP * DM, a.out, nullptr, ssb + 3 * SS_STRIDE, 0.5f};
        pg8::gemm_phase<pg8::EpiResid, pg8::StaticOrder, true, true>(ring, g, S, E); SEAM(10); }
    if (IN(11)) { phase_final(C, a); }
#undef IN
#undef SEAM
}

extern "C" void kernel_launch(void* const* d_in, const int* in_sizes, int n_in, void* d_out, int out_size, void* d_ws, size_t ws_size, hipStream_t stream) {
    static int grid = 0;
    if (grid == 0) {
        if (n_in != 30 || out_size != (int)O_END || ws_size < WS_END) { fprintf(stderr, "kernel_launch: unexpected shapes: n_in %d out %d ws %zu (need %zu)\n", n_in, out_size, ws_size, (size_t)WS_END); grid = -1; return; }
        int dev = 0, cus = 0;
        if (hipGetDevice(&dev) != hipSuccess || hipDeviceGetAttribute(&cus, hipDeviceAttributeMultiprocessorCount, dev) != hipSuccess) { grid = -1; return; }
        if (hipFuncSetAttribute((const void*)mk_fwd, hipFuncAttributeMaxDynamicSharedMemorySize, LDS_BYTES) != hipSuccess) { fprintf(stderr, "kernel_launch: hipFuncSetAttribute failed\n"); grid = -1; return; }
        int per_cu = 0;
        if (hipOccupancyMaxActiveBlocksPerMultiprocessor(&per_cu, (const void*)mk_fwd, NWAVES * 64, LDS_BYTES) != hipSuccess || per_cu < 1) fprintf(stderr, "kernel_launch: occupancy query says %d\n", per_cu);
        (void)hipGetLastError();
        grid = cus;
    }
    if (grid < 0) return;
    if (hipMemsetAsync((char*)d_ws + WS_CTL, 0, CTL_ZERO_BYTES, stream) != hipSuccess) { fprintf(stderr, "kernel_launch: memset failed\n"); return; }
    Args a{};
    for (int i = 0; i < 30; ++i) a.in[i] = (const float*)d_in[i];
    a.out = (float*)d_out; a.ws = (unsigned char*)d_ws;
    if (MK_N_LAUNCHES == 1) { a.ph_lo = 0; a.ph_hi = N_PHASES; hipLaunchKernelGGL(mk_fwd, dim3(grid), dim3(NWAVES * 64), LDS_BYTES, stream, a); }
    else for (int p = 0; p < N_PHASES; ++p) { a.ph_lo = p; a.ph_hi = p + 1; hipLaunchKernelGGL(mk_fwd, dim3(grid), dim3(NWAVES * 64), LDS_BYTES, stream, a); }
    const hipError_t le = hipPeekAtLastError();
    if (le != hipSuccess) fprintf(stderr, "kernel_launch: launch failed: %s\n", hipGetErrorName(le));
}
```

```cpp
#include <hip/hip_runtime.h>
#include <cstdio>
#include <cstdint>
#define MK_N_LAUNCHES 1
namespace pg8 {
#define PG8_LAS __attribute__((address_space(3)))
typedef unsigned short bf16_t;
typedef short bf16x8 __attribute__((ext_vector_type(8)));
typedef float f32x4 __attribute__((ext_vector_type(4)));
typedef unsigned u32x4 __attribute__((ext_vector_type(4)));
constexpr int BM = 256, BK = 64, HALF = 128, HTB = HALF * BK * 2  , STAGE_BYTES = 8 * HTB, NXCD = 8, WGM = 8;

__host__ __device__ __forceinline__ int lds_byte(int r, int c) { const int st = (r >> 4) * 2 + (c >> 5), rr = r & 15, cc = c & 31, ob = rr * 64 + cc * 2; return st * 1024 + (ob ^ (((ob >> 9) & 1) << 5)); }
__host__ __device__ __forceinline__ void stage_rc(int b, int& R, int& C) { const int st = b / 1024, sb = b % 1024, swz = sb ^ (((sb >> 9) & 1) << 5); R = (st >> 1) * 16 + swz / 64; C = (st & 1) * 32 + (swz % 64) / 2; }
__host__ __device__ __forceinline__ int perm32(int rho) { const int n = rho >> 4, i = rho & 15; return 8 * (i >> 2) + 4 * n + (i & 3); }

struct Unit { int pm, pn, k0, nt, kind; };
struct Gemm { const bf16_t* A; const bf16_t* Bt; int M, N, K; };

struct StaticOrder {
    int nM, nN, nwg, G, c, ntf;
    __host__ __device__ void init(int M, int N, int K, int G_, int c_) { nM = M / BM; nN = N / BM; nwg = nM * nN; G = G_; c = c_; ntf = K / BK; }
    __host__ __device__ bool next(int i, Unit& u) const {
        const long L = (long)i * G + c; if (L >= nwg) return false;
        int wgid = (int)L; { const int q = nwg / NXCD, r = nwg % NXCD, xcd = wgid % NXCD, off = wgid / NXCD; wgid = (xcd < r ? xcd * (q + 1) : r * (q + 1) + (xcd - r) * q) + off; }
        const int nig = WGM * nN, gid = wgid / nig, fm = gid * WGM, gsz = (nM - fm) < WGM ? (nM - fm) : WGM;
        u.pm = fm + ((wgid % nig) % gsz); u.pn = (wgid % nig) / gsz; u.k0 = 0; u.nt = ntf; u.kind = 0; return true;
    }
    __device__ __forceinline__ void a_ready(const Unit&) const {}
    __device__ __forceinline__ void done(const Unit&) const {}
};
struct SliceOrder : StaticOrder {
    int nsl;
    __host__ __device__ void init(int K, int G_, int c_) { StaticOrder::init(8192, 2048, K, G_, c_); nsl = ntf / 4; }
    __host__ __device__ bool next(int i, Unit& u) const {
        const long L = (long)i * G + c;
        if (L < nwg) return StaticOrder::next(i, u);
        const int j = (int)(L - nwg); if (j >= 8 * nsl) return false;
        const int sl = j >> 3; u.pm = 32; u.pn = j & 7; u.k0 = 4 * sl; u.nt = (sl == nsl - 1) ? ntf - 4 * sl : 4; u.kind = 1; return true;
    }
};

__device__ __forceinline__ unsigned cvt_pk_bf16(float lo, float hi) { unsigned r; asm volatile("v_cvt_pk_bf16_f32 %0, %1, %2" : "=v"(r) : "v"(lo), "v"(hi)); return r; }
typedef unsigned u32x2 __attribute__((ext_vector_type(2)));
constexpr int MVALID = 8320, MPROMPT = 8192, DMODEL = 2048;
__device__ __forceinline__ float rs_row(const float* ss, int row) { return __builtin_amdgcn_rsqf(ss[row] * (1.0f / 2048.0f) + 1e-6f); }
__device__ __forceinline__ float silu_mul(float g, float u) { return g * u * __builtin_amdgcn_rcpf(1.0f + __builtin_amdgcn_exp2f(-1.4426950408889634f * g)); }
__device__ __forceinline__ float sigmoid_f(float x) { return __builtin_amdgcn_rcpf(1.0f + __builtin_amdgcn_exp2f(-1.4426950408889634f * x)); }

struct EpiSwiglu {
    static constexpr bool PERM = true, AFTER_DRAIN = false;
    bf16_t* H; const float* ss; int ldh;
    __device__ __forceinline__ void operator()(const f32x4 (&acc)[2][2][4][2], const Unit& u, int wr, int wc, int fr, int fq) const {
        const int row0 = u.pm * BM + wr * 64 + fr, col0 = u.pn * HALF + wc * 32 + 8 * fq;
#pragma unroll
        for (int ai = 0; ai < 2; ++ai)
#pragma unroll
            for (int m = 0; m < 4; ++m) { const int row = row0 + ai * HALF + m * 16; const float rs = rs_row(ss, row);
                const f32x4 g0 = acc[ai][0][m][0] * rs, g1 = acc[ai][0][m][1] * rs, u0 = acc[ai][1][m][0] * rs, u1 = acc[ai][1][m][1] * rs;
                u32x4 w; w.x = cvt_pk_bf16(silu_mul(g0[0], u0[0]), silu_mul(g0[1], u0[1])); w.y = cvt_pk_bf16(silu_mul(g0[2], u0[2]), silu_mul(g0[3], u0[3]));
                w.z = cvt_pk_bf16(silu_mul(g1[0], u1[0]), silu_mul(g1[1], u1[1])); w.w = cvt_pk_bf16(silu_mul(g1[2], u1[2]), silu_mul(g1[3], u1[3]));
                *(u32x4*)(H + (size_t)row * ldh + col0) = w; }
    }
};
struct EpiResid {
    static constexpr bool PERM = true, AFTER_DRAIN = false;
    const float* xin; float* xout; bf16_t* xb; float* ssq; float scale; float* slab;
    __device__ __forceinline__ void operator()(const f32x4 (&acc)[2][2][4][2], const Unit& u, int wr, int wc, int fr, int fq) const {
        const int col0 = u.pn * BM + wc * 32 + 8 * fq;
        if (u.kind == 0) {
            const int row0 = u.pm * BM + wr * 64 + fr;
#pragma unroll
            for (int ai = 0; ai < 2; ++ai)
#pragma unroll
                for (int m = 0; m < 4; ++m) { const int row = row0 + ai * HALF + m * 16; const size_t off = (size_t)row * DMODEL + col0;
                    float part = 0.f;
#pragma unroll
                    for (int bj = 0; bj < 2; ++bj) { const f32x4 x0 = *(const f32x4*)(xin + off + bj * HALF), x1 = *(const f32x4*)(xin + off + bj * HALF + 4);
                        const f32x4 v0 = x0 + acc[ai][bj][m][0] * scale, v1 = x1 + acc[ai][bj][m][1] * scale;
                        part += (v0[0] * v0[0] + v0[1] * v0[1]) + (v0[2] * v0[2] + v0[3] * v0[3]) + (v1[0] * v1[0] + v1[1] * v1[1]) + (v1[2] * v1[2] + v1[3] * v1[3]);
                        *(f32x4*)(xout + off + bj * HALF) = v0; *(f32x4*)(xout + off + bj * HALF + 4) = v1;
                        if (xb) { u32x4 w; w.x = cvt_pk_bf16(v0[0], v0[1]); w.y = cvt_pk_bf16(v0[2], v0[3]); w.z = cvt_pk_bf16(v1[0], v1[1]); w.w = cvt_pk_bf16(v1[2], v1[3]);
                            *(u32x4*)(xb + off + bj * HALF) = w; } }
                    part += __shfl_xor(part, 16); part += __shfl_xor(part, 32);
                    if (fq == 0) atomicAdd(ssq + row, part); }
        } else {
            float* sb = slab + ((size_t)(u.k0 >> 2) * 128 + wr * 64 + fr) * DMODEL + col0;
#pragma unroll
            for (int m = 0; m < 4; ++m)
#pragma unroll
                for (int bj = 0; bj < 2; ++bj) { float* o = sb + (size_t)(m * 16) * DMODEL + bj * HALF; *(f32x4*)o = acc[0][bj][m][0]; *(f32x4*)(o + 4) = acc[0][bj][m][1]; }
        }
    }
};
struct EpiWin {
    static constexpr bool PERM = true, AFTER_DRAIN = false;
    bf16_t* QKV; float* PRW; const float* ss; float* kwin_p; long wins_minus_winp; float qscale;
    __device__ __forceinline__ void operator()(const f32x4 (&acc)[2][2][4][2], const Unit& u, int wr, int wc, int fr, int fq) const {
        const int row0 = u.pm * BM + wr * 64 + fr, c0 = wc * 32 + 8 * fq;
#pragma unroll
        for (int ai = 0; ai < 2; ++ai)
#pragma unroll
            for (int m = 0; m < 4; ++m) { const int row = row0 + ai * HALF + m * 16; const float rs = rs_row(ss, row);
#pragma unroll
                for (int bj = 0; bj < 2; ++bj) { const f32x4 v0 = acc[ai][bj][m][0] * rs, v1 = acc[ai][bj][m][1] * rs; const int c256 = bj * HALF + c0;
                    if (u.pn < 6) { const float sc = u.pn < 4 ? qscale : 1.0f;
                        u32x4 w; w.x = cvt_pk_bf16(v0[0] * sc, v0[1] * sc); w.y = cvt_pk_bf16(v0[2] * sc, v0[3] * sc); w.z = cvt_pk_bf16(v1[0] * sc, v1[1] * sc); w.w = cvt_pk_bf16(v1[2] * sc, v1[3] * sc);
                        *(u32x4*)(QKV + (size_t)row * 1536 + u.pn * BM + c256) = w;
                        if (u.pn >= 4) { long off = -1; const bool isp = row < MPROMPT; const long kv = u.pn - 4;
                            if (isp) { const int t = row & 2047; if (t >= 1920) off = kv * 131072 + (long)((row >> 11) * 128 + (t - 1920)) * 256 + c256; }
                            else if (row < MVALID) off = (long)(wins_minus_winp) + kv * 4194304 + (long)((row - MPROMPT) * 128 + 127) * 256 + c256;
                            if (off >= 0) { *(f32x4*)(kwin_p + off) = v0; *(f32x4*)(kwin_p + off + 4) = v1; } }
                    } else { float* o = PRW + (size_t)row * 3584 + (u.pn - 6) * BM + c256; *(f32x4*)o = v0; *(f32x4*)(o + 4) = v1; } } }
    }
};
struct EpiLora {
    static constexpr bool PERM = true, AFTER_DRAIN = false;
    float* LWW; long lwa_minus_lww; bf16_t* LWG; const float* dbase; long ibase_minus_dbase;
    __device__ __forceinline__ void operator()(const f32x4 (&acc)[2][2][4][2], const Unit& u, int wr, int wc, int fr, int fq) const {
        const int row0 = u.pm * BM + wr * 64 + fr, seg = u.pn >> 2, cb = (u.pn & 3) * BM + wc * 32 + 8 * fq;
#pragma unroll
        for (int bj = 0; bj < 2; ++bj) { const int col = cb + bj * HALF;
            f32x4 b0 = (f32x4){0.f, 0.f, 0.f, 0.f}, b1 = b0;
            if (seg < 2) { const float* bp = dbase + (seg ? ibase_minus_dbase : 0) + col; b0 = *(const f32x4*)bp; b1 = *(const f32x4*)(bp + 4); }
#pragma unroll
            for (int ai = 0; ai < 2; ++ai)
#pragma unroll
                for (int m = 0; m < 4; ++m) { const int row = row0 + ai * HALF + m * 16; const f32x4 v0 = acc[ai][bj][m][0] + b0, v1 = acc[ai][bj][m][1] + b1;
                    if (seg == 2) { u32x4 w; w.x = cvt_pk_bf16(v0[0], v0[1]); w.y = cvt_pk_bf16(v0[2], v0[3]); w.z = cvt_pk_bf16(v1[0], v1[1]); w.w = cvt_pk_bf16(v1[2], v1[3]);
                        *(u32x4*)(LWG + (size_t)row * 1024 + col) = w; }
                    else { float* o = LWW + (seg ? lwa_minus_lww : 0) + (size_t)row * 1024 + col; *(f32x4*)o = v0; *(f32x4*)(o + 4) = v1; } } }
    }
};
template <class Epi, class Sched, bool ALIGN_EPI = false, bool SP2 = false>
__device__ __forceinline__ void gemm_phase(PG8_LAS unsigned char* lds, const Gemm g, const Sched& S, const Epi& E) {
    const int tid = threadIdx.x, wid = __builtin_amdgcn_readfirstlane(tid >> 6), lane = tid & 63, wr = wid >> 2, wc = wid & 3, fr = lane & 15, fq = lane >> 4;
    const int K = g.K;
    unsigned voffA[2], voffB[2];
#pragma unroll
    for (int i = 0; i < 2; ++i) { int R, C; stage_rc(tid * 16 + i * 8192, R, C); const int Rb = Epi::PERM ? ((R & ~31) + perm32(R & 31)) : R;
        voffA[i] = (unsigned)(R * K + C) * 2u; voffB[i] = (unsigned)(Rb * K + C) * 2u; }
    const size_t kstep = (size_t)(BK * 2);
    const size_t hstep = (size_t)HALF * K * 2;
    const size_t tstep = 2 * hstep;
    const unsigned ldsw = (unsigned)wid * 1024u;
    const int aoff = lds_byte(wr * 64 + fr, fq * 8), boff = lds_byte(wc * 32 + fr, fq * 8);
#define PG8_SA(b, h) (((b) * 2 + (h)) * HTB)
#define PG8_SB(b, h) ((4 + (b) * 2 + (h)) * HTB)
#define PG8_STAGE(bufoff, gbase, voff) do { _Pragma("unroll") for (int _i = 0; _i < 2; ++_i) \
        __builtin_amdgcn_global_load_lds((const unsigned*)((const char*)(gbase) + (voff)[_i]), (PG8_LAS unsigned*)(lds + (bufoff) + ldsw + _i * 8192), 16, 0, 0); } while (0)
#define PG8_LDA(dst, b, h) do { _Pragma("unroll") for (int m = 0; m < 4; ++m) _Pragma("unroll") for (int k = 0; k < 2; ++k) dst[m][k] = *(const PG8_LAS bf16x8*)(lds + PG8_SA(b, h) + aoff + m * 2048 + k * 1024); } while (0)
#define PG8_LDB(dst, b, h) do { _Pragma("unroll") for (int n = 0; n < 2; ++n) _Pragma("unroll") for (int k = 0; k < 2; ++k) dst[n][k] = *(const PG8_LAS bf16x8*)(lds + PG8_SB(b, h) + boff + n * 2048 + k * 1024); } while (0)
#define PG8_MMA(ai, bj, At, Bt) do { __builtin_amdgcn_s_setprio(1); _Pragma("unroll") for (int m = 0; m < 4; ++m) _Pragma("unroll") for (int n = 0; n < 2; ++n) _Pragma("unroll") for (int k = 0; k < 2; ++k) \
        acc[ai][bj][m][n] = __builtin_amdgcn_mfma_f32_16x16x32_bf16(Bt[n][k], At[m][k], acc[ai][bj][m][n], 0, 0, 0); __builtin_amdgcn_s_setprio(0); } while (0)
#define PG8_WAIT_V(n) asm volatile("s_waitcnt vmcnt(" #n ")" ::: "memory")
#define PG8_WAIT_L(n) asm volatile("s_waitcnt lgkmcnt(" #n ")" ::: "memory")
#define PG8_BAR __builtin_amdgcn_s_barrier()
#define PG8_SCHED __builtin_amdgcn_sched_barrier(0)
    Unit cur, nxt; int ui = 0;
    if (!S.next(0, cur)) return;
    f32x4 acc[2][2][4][2];
#pragma unroll
    for (int a = 0; a < 2; ++a)
#pragma unroll
        for (int b = 0; b < 2; ++b)
#pragma unroll
            for (int m = 0; m < 4; ++m)
#pragma unroll
                for (int n = 0; n < 2; ++n) acc[a][b][m][n] = (f32x4){0.f, 0.f, 0.f, 0.f};
    bf16x8 At[4][2], B0[2][2], B1[2][2];
    const char* cA = (const char*)g.A + (size_t)cur.pm * tstep + (size_t)cur.k0 * kstep; const char* cB = (const char*)g.Bt + (size_t)cur.pn * tstep + (size_t)cur.k0 * kstep;
    S.a_ready(cur);
    if constexpr (SP2) {
        PG8_STAGE(PG8_SB(0, 0), cB, voffB); PG8_STAGE(PG8_SB(0, 1), cB + hstep, voffB); PG8_STAGE(PG8_SA(0, 0), cA, voffA); PG8_STAGE(PG8_SA(0, 1), cA + hstep, voffA);
        if (wr == 1) PG8_BAR;
        PG8_WAIT_V(2); PG8_BAR;
        PG8_STAGE(PG8_SB(1, 0), cB + kstep, voffB); PG8_STAGE(PG8_SA(1, 0), cA + kstep, voffA); PG8_STAGE(PG8_SB(1, 1), cB + hstep + kstep, voffB);
        PG8_WAIT_V(6); PG8_BAR;
    } else {
        PG8_STAGE(PG8_SB(0, 0), cB, voffB); PG8_STAGE(PG8_SA(0, 0), cA, voffA); PG8_STAGE(PG8_SB(0, 1), cB + hstep, voffB); PG8_STAGE(PG8_SA(0, 1), cA + hstep, voffA);
        if (wr == 1) PG8_BAR;
        PG8_WAIT_V(4); PG8_BAR;
        PG8_STAGE(PG8_SB(1, 0), cB + kstep, voffB); PG8_STAGE(PG8_SA(1, 0), cA + kstep, voffA); PG8_STAGE(PG8_SB(1, 1), cB + hstep + kstep, voffB);
        PG8_WAIT_V(6); PG8_BAR;
    }
    for (;;) {
        const bool has_next = S.next(ui + 1, nxt);
        const char* nA = has_next ? (const char*)g.A + (size_t)nxt.pm * tstep + (size_t)nxt.k0 * kstep : cA; const char* nB = has_next ? (const char*)g.Bt + (size_t)nxt.pn * tstep + (size_t)nxt.k0 * kstep : cB;
        const int nt = cur.nt;
#pragma unroll 1
        for (int t = 0; t < nt; t += 2) {
            const bool last = (t == nt - 2);
            const char* a1 = cA + (size_t)(t + 1) * kstep;
            const char* a2 = last ? nA : cA + (size_t)(t + 2) * kstep; const char* b2 = last ? nB : cB + (size_t)(t + 2) * kstep;
            const char* a3 = a2 + kstep; const char* b3 = b2 + kstep;
            if (last && has_next) S.a_ready(nxt);
            if constexpr (SP2) {
            PG8_LDB(B0, 0, 0); PG8_LDB(B1, 0, 1); PG8_SCHED; PG8_LDA(At, 0, 0); PG8_STAGE(PG8_SA(1, 1), a1 + hstep, voffA);
            PG8_WAIT_V(8); PG8_WAIT_L(0); PG8_BAR; PG8_MMA(0, 0, At, B0); PG8_MMA(0, 1, At, B1); PG8_BAR; PG8_SCHED;
            PG8_LDA(At, 0, 1); PG8_STAGE(PG8_SB(0, 0), b2, voffB); PG8_STAGE(PG8_SB(0, 1), b2 + hstep, voffB); PG8_STAGE(PG8_SA(0, 0), a2, voffA);
            PG8_WAIT_V(8); PG8_WAIT_L(0); PG8_BAR; PG8_MMA(1, 0, At, B0); PG8_MMA(1, 1, At, B1); PG8_BAR; PG8_SCHED;
            PG8_LDB(B0, 1, 0); PG8_LDB(B1, 1, 1); PG8_SCHED; PG8_LDA(At, 1, 0); PG8_STAGE(PG8_SA(0, 1), a2 + hstep, voffA);
            PG8_WAIT_V(8); PG8_WAIT_L(0); PG8_BAR; PG8_MMA(0, 0, At, B0); PG8_MMA(0, 1, At, B1); PG8_BAR; PG8_SCHED;
            PG8_LDA(At, 1, 1); PG8_STAGE(PG8_SB(1, 0), b3, voffB); PG8_STAGE(PG8_SB(1, 1), b3 + hstep, voffB); PG8_STAGE(PG8_SA(1, 0), a3, voffA);
            PG8_WAIT_V(8); PG8_WAIT_L(0); PG8_BAR; PG8_MMA(1, 0, At, B0); PG8_MMA(1, 1, At, B1); PG8_BAR; PG8_SCHED;
            } else {
            PG8_LDB(B0, 0, 0); PG8_SCHED; PG8_LDA(At, 0, 0); PG8_STAGE(PG8_SA(1, 1), a1 + hstep, voffA);
            PG8_WAIT_L(8); PG8_BAR; PG8_WAIT_L(0); PG8_MMA(0, 0, At, B0); PG8_BAR; PG8_SCHED;
            PG8_LDB(B1, 0, 1); PG8_STAGE(PG8_SB(0, 0), b2, voffB);
            PG8_BAR; PG8_WAIT_L(0); PG8_MMA(0, 1, At, B1); PG8_BAR;
            PG8_LDA(At, 0, 1); PG8_STAGE(PG8_SA(0, 0), a2, voffA);
            PG8_BAR; PG8_WAIT_L(0); PG8_MMA(1, 0, At, B0); PG8_BAR; PG8_SCHED;
            PG8_STAGE(PG8_SB(0, 1), b2 + hstep, voffB);
            PG8_WAIT_V(6); PG8_BAR; PG8_MMA(1, 1, At, B1); PG8_BAR;
            PG8_LDB(B0, 1, 0); PG8_SCHED; PG8_LDA(At, 1, 0); PG8_STAGE(PG8_SA(0, 1), a2 + hstep, voffA);
            PG8_WAIT_L(8); PG8_BAR; PG8_WAIT_L(0); PG8_MMA(0, 0, At, B0); PG8_BAR; PG8_SCHED;
            PG8_LDB(B1, 1, 1); PG8_STAGE(PG8_SB(1, 0), b3, voffB);
            PG8_BAR; PG8_WAIT_L(0); PG8_MMA(0, 1, At, B1); PG8_BAR;
            PG8_LDA(At, 1, 1); PG8_STAGE(PG8_SA(1, 0), a3, voffA);
            PG8_BAR; PG8_WAIT_L(0); PG8_MMA(1, 0, At, B0); PG8_BAR; PG8_SCHED;
            PG8_STAGE(PG8_SB(1, 1), b3 + hstep, voffB);
            PG8_WAIT_V(6); PG8_BAR; PG8_MMA(1, 1, At, B1); PG8_BAR;
            }
        }
        if constexpr (ALIGN_EPI) { if (wr == 0) PG8_BAR; }
        if constexpr (!Epi::AFTER_DRAIN) { E(acc, cur, wr, wc, fr, fq); S.done(cur); }
        if (!has_next) break;
#pragma unroll
        for (int a = 0; a < 2; ++a)
#pragma unroll
            for (int b = 0; b < 2; ++b)
#pragma unroll
                for (int m = 0; m < 4; ++m)
#pragma unroll
                    for (int n = 0; n < 2; ++n) acc[a][b][m][n] = (f32x4){0.f, 0.f, 0.f, 0.f};
        cur = nxt; cA = nA; cB = nB; ++ui;
        if constexpr (ALIGN_EPI) { if (wr == 1) PG8_BAR; }
    }
    PG8_WAIT_V(0);
    if constexpr (!ALIGN_EPI) { if (wr == 0) PG8_BAR; }
    PG8_BAR;
    if constexpr (Epi::AFTER_DRAIN) { E.fused(acc, cur, wr, wc, fr, fq, lds, wid, lane); S.done(cur); }
#undef PG8_SA
#undef PG8_SB
#undef PG8_STAGE
#undef PG8_LDA
#undef PG8_LDB
#undef PG8_MMA
#undef PG8_WAIT_V
#undef PG8_WAIT_L
#undef PG8_BAR
#undef PG8_SCHED
}
}

constexpr int NWAVES = 8;
#ifndef MK_N_LAUNCHES
#define MK_N_LAUNCHES 1
#endif
constexpr int N_PHASES = 14;
constexpr int DM = 2048, TSEQ = 2048, NBATCH = 4, MP = 8192, NSAMP = 128, MV = 8320, MPAD = 8448, FF = 5504, NQKV = 1536, NRW = 3360, NRWP = 3584, NIN = 5120, KL = 384, NL = 3072;
using pg8::sigmoid_f;
constexpr float QSCALE = 0.125f * 1.4426950408889634f, LOG2E = 1.4426950408889634f;
constexpr size_t O_YP = 0, O_YS = 16777216, O_PSHIFT = 17039360, O_PWKV = 17052800, O_PKWIN = 17314944, O_PVWIN = 17446016, O_SSHIFT = 17577088, O_SWKV = 18007168, O_SKWIN = 26395776, O_SVWIN = 30590080, O_END = 34784384;
constexpr size_t MiB = 1u << 20;
constexpr size_t WS_CTL = 0, CTL_ZERO_BYTES = 1 * MiB;
constexpr size_t WS_W1T = 1 * MiB, WS_W2T = 44 * MiB, WS_WINT = 66 * MiB, WS_WOUTT = 86 * MiB, WS_WLT = 94 * MiB, WS_XB = 97 * MiB, WS_H = 130 * MiB, WS_PRW = 219 * MiB, WS_QKV = 335 * MiB, WS_OMIX = 360 * MiB, WS_END = 393 * MiB;
constexpr size_t WS_LWW = WS_H, WS_LWA = WS_H + (size_t)MPAD * 1024 * 4, WS_LWG = WS_H + (size_t)MPAD * 1024 * 8, WS_ALORA = WS_H + (size_t)MPAD * 1024 * 10;
constexpr size_t WS_ORAW = WS_XB;
static_assert(WS_ALORA + (size_t)MPAD * KL * 2 <= WS_H + (size_t)MPAD * FF * 2 && WS_H + (size_t)MPAD * FF * 2 <= WS_PRW && WS_PRW + (size_t)MPAD * NRWP * 4 <= WS_QKV && WS_QKV + (size_t)MPAD * NQKV * 2 <= WS_OMIX && WS_OMIX + (size_t)MPAD * DM * 2 <= WS_END, "ws map");
static_assert(WS_W1T + (size_t)2 * FF * DM * 2 <= WS_W2T && WS_W2T + (size_t)FF * DM * 2 <= WS_WINT && WS_WINT + (size_t)NIN * DM * 2 <= WS_WOUTT && WS_WOUTT + (size_t)DM * DM * 2 <= WS_WLT && WS_WLT + (size_t)NL * KL * 2 <= WS_XB && WS_XB + (size_t)MPAD * DM * 2 <= WS_H, "ws map 2");
constexpr int CW_BAR = 4096, CW_SS = 16384, SS_STRIDE = 16384, CW_ZROW = 131072;
constexpr int RING_BYTES = 131072, LDSCTL_OFF = RING_BYTES, MISC_OFF = LDSCTL_OFF + 320, LDS_BYTES = 147456;

#define GAS __attribute__((address_space(1)))
#define LAS __attribute__((address_space(3)))
typedef unsigned short bf16;
typedef unsigned v4u __attribute__((ext_vector_type(4)));
typedef unsigned v2u __attribute__((ext_vector_type(2)));
typedef float f32x4 __attribute__((ext_vector_type(4)));
typedef short bf16x8 __attribute__((ext_vector_type(8)));
typedef short s16x4 __attribute__((ext_vector_type(4)));
#define LDS_WAIT() asm volatile("s_waitcnt lgkmcnt(0)" ::: "memory")
#define VM_WAIT() asm volatile("s_waitcnt vmcnt(0)" ::: "memory")
__device__ __forceinline__ unsigned f2bf(float f) { unsigned u = __builtin_bit_cast(unsigned, f); return (u + 0x7fffu + ((u >> 16) & 1u)) >> 16; }
__device__ __forceinline__ unsigned pk2(float lo, float hi) { return f2bf(lo) | (f2bf(hi) << 16); }
__device__ __forceinline__ float bf2f(unsigned short b) { return __builtin_bit_cast(float, (unsigned)b << 16); }
__device__ __forceinline__ float bflo(unsigned w) { return __builtin_bit_cast(float, w << 16); }
__device__ __forceinline__ float bfhi(unsigned w) { return __builtin_bit_cast(float, w & 0xffff0000u); }
#define XB_TMO      128
#define XB_XCNT(j)  (256  + 64 * (j))
#define XB_XSUB(j)  (1280 + 64 * (j))
#define XB_XGEN(j)  (2304 + 64 * (j))
#define XB_TOP      3328
#define XB_TOPGEN   3392
#define XCD_BAR_WORDS 3456
#define XB_SPIN_CAP (1u << 18)

__device__ __forceinline__ unsigned xb_ld(unsigned* p)              { return __hip_atomic_load(p, __ATOMIC_RELAXED, __HIP_MEMORY_SCOPE_AGENT); }
__device__ __forceinline__ unsigned xb_add(unsigned* p, unsigned v) { return __hip_atomic_fetch_add(p, v, __ATOMIC_RELAXED, __HIP_MEMORY_SCOPE_AGENT); }
__device__ __forceinline__ unsigned xb_xcc_id() { return (unsigned)__builtin_amdgcn_s_getreg((3 << 11) | 20) & 0xFu; }
#define XB_SPIN(cond, bar) do { unsigned _sp = 0; while (cond) { __builtin_amdgcn_s_sleep(1); \
    if ((++_sp & 255u) == 0u) { if (xb_ld(&(bar)[XB_TMO])) break; if (_sp > XB_SPIN_CAP) { atomicAdd(&(bar)[XB_TMO], 1u); break; } } } } while (0)

struct XcdBarrier {
    unsigned* bar; unsigned x;
    volatile LAS unsigned* st;
};

__device__ __forceinline__ XcdBarrier xcd_barrier_post(unsigned* bar, volatile LAS unsigned* st) {
    XcdBarrier b; b.bar = bar; b.x = xb_xcc_id(); b.st = st;
    if (threadIdx.x == 0) (void)xb_add(&bar[XB_XCNT(b.x)], 1u);
    return b;
}
__device__ __forceinline__ void xcd_barrier_complete(unsigned* bar, unsigned x, unsigned& nloc, unsigned& nx) {
    const unsigned G = gridDim.x * gridDim.y * gridDim.z;
    unsigned sum, cnt, mine, sp = 0u;
    for (;;) {
        sum = 0u; cnt = 0u; mine = 0u;
#pragma unroll
        for (unsigned j = 0; j < 16; ++j) { const unsigned c = xb_ld(&bar[XB_XCNT(j)]); sum += c; cnt += (c > 0u) ? 1u : 0u; mine = (j == x) ? c : mine; }
        if (sum == G) break;
        __builtin_amdgcn_s_sleep(1);
        if ((++sp & 255u) == 0u) { if (xb_ld(&bar[XB_TMO])) break; if (sp > XB_SPIN_CAP) { atomicAdd(&bar[XB_TMO], 1u); break; } }
    }
    nloc = mine > 0u ? mine : 1u; nx = cnt > 0u ? cnt : 1u;
}

__device__ __forceinline__ void xcd_barrier(const XcdBarrier& b) {
    asm volatile("s_waitcnt vmcnt(0)" ::: "memory");
    __syncthreads();
    if (threadIdx.x == 0) {
        unsigned* bar = b.bar;
        __builtin_amdgcn_s_waitcnt(0);
        unsigned nloc = b.st[0], nx = b.st[1];
        if (nloc == 0u) { xcd_barrier_complete(bar, b.x, nloc, nx); b.st[0] = nloc; b.st[1] = nx; }
        const unsigned old = xb_add(&bar[XB_XSUB(b.x)], 1u);
        const unsigned gen = old / nloc;
        if (old + 1u == (gen + 1u) * nloc) {
            __builtin_amdgcn_fence(__ATOMIC_RELEASE, "agent");
            asm volatile("s_waitcnt vmcnt(0)" ::: "memory");
            const unsigned og = xb_add(&bar[XB_TOP], 1u);
            const unsigned tg = og / nx;
            if (og + 1u == (tg + 1u) * nx) xb_add(&bar[XB_TOPGEN], 1u);
            else XB_SPIN(xb_ld(&bar[XB_TOPGEN]) == tg, bar);
            __builtin_amdgcn_fence(__ATOMIC_ACQUIRE, "agent");
            xb_add(&bar[XB_XGEN(b.x)], 1u);
            asm volatile("s_waitcnt vmcnt(0)" ::: "memory");
        } else {
            XB_SPIN(xb_ld(&bar[XB_XGEN(b.x)]) == gen, bar);
            __builtin_amdgcn_fence(__ATOMIC_ACQUIRE, "agent");
            asm volatile("s_waitcnt vmcnt(0)" ::: "memory");
        }
    }
    __syncthreads();
}
struct Args { const float* in[30]; float* out; unsigned char* ws; int ph_lo, ph_hi; };
enum { I_XP = 0, I_XS, I_SSHIFT, I_SWKV, I_CK, I_CV, I_N1, I_W1G, I_W1U, I_W1D, I_NMIX, I_WIN, I_MU, I_DUP, I_DBASE, I_IUP, I_IBASE, I_GUP, I_KK, I_KA, I_RK, I_LNG, I_LNB, I_SINK, I_WOUT, I_N2, I_W2G, I_W2U, I_W2D, I_NF };

struct Ctx { LAS unsigned char* lds; int tid, lane, wave, gw, ngw; };

template <int CTRL> __device__ __forceinline__ float dpp_f(float x) { return __builtin_bit_cast(float, __builtin_amdgcn_mov_dpp(__builtin_bit_cast(int, x), CTRL, 0xf, 0xf, true)); }
__device__ __forceinline__ float red8(float x) { x += dpp_f<0xB1>(x); x += dpp_f<0x4E>(x); x += dpp_f<0x141>(x); return x; }
__device__ __forceinline__ float red16(float x) { x = red8(x); x += dpp_f<0x140>(x); return x; }
__device__ __forceinline__ float wave_sum(float v) {
#pragma unroll
    for (int o = 1; o < 64; o <<= 1) v += __shfl_xor(v, o);
    return v;
}
__device__ __forceinline__ float wave_max(float v) {
#pragma unroll
    for (int o = 1; o < 64; o <<= 1) v = fmaxf(v, __shfl_xor(v, o));
    return v;
}
__device__ __forceinline__ float dot4(f32x4 a, f32x4 b) { return (a[0] * b[0] + a[1] * b[1]) + (a[2] * b[2] + a[3] * b[3]); }

template <int MODE> __device__ __forceinline__ void tr_item(const float* W, int K, int N, const float* gain, bf16* WT, LAS float* scr, int item, int lane) {
    const int nblk = N / 32, kb = item / nblk, nb = item % nblk, k0 = 64 * kb, n0 = 32 * nb;
#pragma unroll 8
    for (int i = 0; i < 32; ++i) { const int kk = 2 * i + (lane >> 5); float v = W[(size_t)(k0 + kk) * N + n0 + (lane & 31)]; if (gain) v *= gain[k0 + kk]; scr[kk * 33 + (lane & 31)] = v; }
    LDS_WAIT(); asm volatile("" ::: "memory");
    const int c = lane & 7;
    const int r0 = MODE == 0 ? n0 : (256 * (n0 >> 7) + (n0 & 127) + (MODE == 2 ? 128 : 0));
#pragma unroll
    for (int j = 0; j < 4; ++j) { const int n = (lane >> 3) + 8 * j; const LAS float* s = scr + (8 * c) * 33 + n;
        v4u o; o.x = pk2(s[0 * 33], s[1 * 33]); o.y = pk2(s[2 * 33], s[3 * 33]); o.z = pk2(s[4 * 33], s[5 * 33]); o.w = pk2(s[6 * 33], s[7 * 33]);
        *(v4u*)(WT + (size_t)(r0 + n) * K + k0 + 8 * c) = o; }
    LDS_WAIT(); asm volatile("" ::: "memory");
}
__device__ __forceinline__ void convert_ffn(const Ctx& C, const float* Wg, const float* Wu, const float* Wd, const float* gain, bf16* W1T, bf16* W2T) {
    LAS float* scr = (LAS float*)(C.lds + C.wave * 16384);
    constexpr int I_G = (DM / 64) * (FF / 32), I_D = (FF / 64) * (DM / 32);
    for (int it = C.gw; it < 2 * I_G + I_D; it += C.ngw) {
        int r = it;
        if (r < I_G) { tr_item<1>(Wg, DM, FF, gain, W1T, scr, r, C.lane); continue; } r -= I_G;
        if (r < I_G) { tr_item<2>(Wu, DM, FF, gain, W1T, scr, r, C.lane); continue; } r -= I_G;
        tr_item<0>(Wd, FF, DM, nullptr, W2T, scr, r, C.lane);
    }
}

__device__ __forceinline__ void phase_prologue(const Ctx& C, const Args& a) {
    unsigned char* ws = a.ws;
    convert_ffn(C, a.in[I_W1G], a.in[I_W1U], a.in[I_W1D], a.in[I_N1], (bf16*)(ws + WS_W1T), (bf16*)(ws + WS_W2T));
    {
        LAS float* scr = (LAS float*)(C.lds + C.wave * 16384);
        constexpr int I_IN = (DM / 64) * (4896 / 32), I_OUT = (DM / 64) * (DM / 32);
        for (int it = C.gw; it < I_IN + I_OUT; it += C.ngw) {
            if (it < I_IN) tr_item<0>(a.in[I_WIN], DM, 4896, a.in[I_NMIX], (bf16*)(ws + WS_WINT), scr, it, C.lane);
            else tr_item<0>(a.in[I_WOUT], DM, DM, nullptr, (bf16*)(ws + WS_WOUTT), scr, it - I_IN, C.lane);
        }
    }
    {
        v4u* z = (v4u*)((bf16*)(ws + WS_WINT) + (size_t)4896 * DM);
        for (int i = C.gw * 64 + C.lane; i < 224 * DM / 8; i += C.ngw * 64) z[i] = (v4u){0u, 0u, 0u, 0u};
    }
    {
        bf16* WL = (bf16*)(ws + WS_WLT);
        for (int e = C.gw * 64 + C.lane; e < KL * NL; e += C.ngw * 64) { const int k = e / NL, n = e % NL; float v = 0.f;
            if (n < 1024) { if (k < 64) v = a.in[I_DUP][k * 1024 + n]; }
            else if (n < 2048) { if (k >= 64 && k < 128) v = a.in[I_IUP][(k - 64) * 1024 + (n - 1024)]; }
            else { if (k >= 128 && k < 288) v = a.in[I_GUP][(k - 128) * 1024 + (n - 2048)]; }
            WL[(size_t)n * KL + k] = (bf16)f2bf(v); }
    }
    {
        bf16* XB = (bf16*)(ws + WS_XB); float* ss1 = (float*)(ws + WS_CTL) + CW_SS;
        for (int m = C.gw; m < MPAD; m += C.ngw) {
            const float* xr = m < MP ? a.in[I_XP] + (size_t)m * DM : a.in[I_XS] + (size_t)(m - MP) * DM;
            float s = 0.f;
#pragma unroll
            for (int j = 0; j < 8; ++j) { f32x4 v = (f32x4){0.f, 0.f, 0.f, 0.f}; if (m < MV) v = *((const f32x4*)xr + C.lane + 64 * j);
                s += dot4(v, v); v2u o; o.x = pk2(v[0], v[1]); o.y = pk2(v[2], v[3]); *((v2u*)(XB + (size_t)m * DM) + C.lane + 64 * j) = o; }
            s = wave_sum(s); if (C.lane == 0) ss1[m] = s;
        }
    }
}

struct Ops { f32x4 na, w, b, kp, r, v; };
__device__ __forceinline__ f32x4 sig4(f32x4 x) { return (f32x4){sigmoid_f(x[0]), sigmoid_f(x[1]), sigmoid_f(x[2]), sigmoid_f(x[3])}; }
__device__ __forceinline__ f32x4 decay4(f32x4 x) { const f32x4 s = sig4(x); return (f32x4){__builtin_amdgcn_exp2f(-0.8750387749f * s[0]), __builtin_amdgcn_exp2f(-0.8750387749f * s[1]), __builtin_amdgcn_exp2f(-0.8750387749f * s[2]), __builtin_amdgcn_exp2f(-0.8750387749f * s[3])}; }
struct RwConst { const float* mu; const float* k_k; const float* k_a; };
template <bool WITH_W> __device__ __forceinline__ void prep_ops(Ops& o, const float* prow, const float* pprev, const float* wrow, const float* arow, const RwConst& rc, int hk) {
    const f32x4 pr = *(const f32x4*)(prow + hk), pk = *(const f32x4*)(prow + 1024 + hk), pv = *(const f32x4*)(prow + 2048 + hk);
    const f32x4 qr = *(const f32x4*)(pprev + hk), qk = *(const f32x4*)(pprev + 1024 + hk), qv = *(const f32x4*)(pprev + 2048 + hk);
    const f32x4 mr = *(const f32x4*)(rc.mu + hk), mk = *(const f32x4*)(rc.mu + 1024 + hk), mv = *(const f32x4*)(rc.mu + 2048 + hk);
    const f32x4 a4 = sig4(*(const f32x4*)(arow + hk)), kk4 = *(const f32x4*)(rc.k_k + hk), ka4 = *(const f32x4*)(rc.k_a + hk);
    const f32x4 ur = pr + mr * (qr - pr), uk = pk + mk * (qk - pk), uv = pv + mv * (qv - pv);
    const f32x4 kk = uk * kk4;
    const float n2 = red16(dot4(kk, kk));
    const float inv = 1.0f / fmaxf(sqrtf(n2), 1e-12f);
    const f32x4 kkn = kk * inv;
    o.na = -kkn; o.b = kkn * a4; o.kp = uk * (1.0f + (a4 - 1.0f) * ka4); o.r = ur; o.v = uv;
    if (WITH_W) o.w = decay4(*(const f32x4*)(wrow + hk)); else o.w = (f32x4){0.f, 0.f, 0.f, 0.f};
}

typedef short v4i16_t __attribute__((ext_vector_type(4)));
constexpr int AT_STRIDE = 160, AT_ROWS = 272, AT_KOFF = 0, AT_VOFF = AT_ROWS * AT_STRIDE, AT_END = 2 * AT_ROWS * AT_STRIDE;
__device__ __forceinline__ void attn_prompt_unit(const Ctx& C, const Args& a, int unit) {
    const bf16* QKV = (const bf16*)(a.ws + WS_QKV); bf16* OMIX = (bf16*)(a.ws + WS_OMIX);
    const int b = unit >> 6, nb = (unit >> 2) & 15, c = unit & 3;
    const int m0 = b * TSEQ + nb * 128;
    LAS unsigned char* Kt = C.lds + AT_KOFF; LAS unsigned char* Vt = C.lds + AT_VOFF;
    __syncthreads();
    for (int i = C.tid; i < 2 * AT_ROWS * 8; i += 512) { const int which = i / (AT_ROWS * 8), r = (i % (AT_ROWS * 8)) >> 3, ch = i & 7;
        v4u v = (v4u){0u, 0u, 0u, 0u};
        if (r < 256 && (nb > 0 || r >= 128)) v = *(const v4u*)(QKV + (size_t)(m0 - 128 + r) * NQKV + 1024 + which * 256 + c * 64 + ch * 8);
        *(LAS v4u*)((which ? Vt : Kt) + r * AT_STRIDE + ch * 16) = v; }
    __syncthreads();
    const int w = C.wave, fr = C.lane & 15, fq = C.lane >> 4;
#pragma unroll 1
    for (int hq = 0; hq < 4; ++hq) { const int h = 4 * c + hq;
        const float slope2 = __builtin_amdgcn_exp2f(-0.5f * (float)(h + 1)) * LOG2E, sink2 = a.in[I_SINK][h] * LOG2E;
        const bf16* qp = QKV + (size_t)(m0 + 16 * w + fr) * NQKV + h * 64 + 8 * fq;
        const bf16x8 q0 = *(const bf16x8*)qp, q1 = *(const bf16x8*)(qp + 32);
        f32x4 s[10];
#pragma unroll
        for (int kt = 0; kt < 10; ++kt) { const LAS unsigned char* kp = Kt + (16 * (w + kt) + fr) * AT_STRIDE + 16 * fq;
            const bf16x8 k0 = *(const LAS bf16x8*)kp, k1 = *(const LAS bf16x8*)(kp + 64);
            f32x4 acc = (f32x4){0.f, 0.f, 0.f, 0.f};
            acc = __builtin_amdgcn_mfma_f32_16x16x32_bf16(k0, q0, acc, 0, 0, 0); acc = __builtin_amdgcn_mfma_f32_16x16x32_bf16(k1, q1, acc, 0, 0, 0);
            s[kt] = acc; }
        const int qi = 16 * w + fr; float mx = sink2;
#pragma unroll
        for (int kt = 0; kt < 10; ++kt)
#pragma unroll
            for (int r = 0; r < 4; ++r) { const int kj = 16 * (w + kt) + 4 * fq + r, dist = 128 + qi - kj; const bool ok = dist >= 0 && dist < 128 && (nb > 0 || kj >= 128);
                const float v = ok ? s[kt][r] - slope2 * (float)dist : -1e30f; s[kt][r] = v; mx = fmaxf(mx, v); }
        mx = fmaxf(mx, __shfl_xor(mx, 16)); mx = fmaxf(mx, __shfl_xor(mx, 32));
        float sum = 0.f;
#pragma unroll
        for (int kt = 0; kt < 10; ++kt)
#pragma unroll
            for (int r = 0; r < 4; ++r) { const float p = __builtin_amdgcn_exp2f(s[kt][r] - mx); s[kt][r] = p; sum += p; }
        sum += __shfl_xor(sum, 16); sum += __shfl_xor(sum, 32);
        const float inv = 1.0f / (sum + __builtin_amdgcn_exp2f(sink2 - mx));
        f32x4 o[4];
#pragma unroll
        for (int dt = 0; dt < 4; ++dt) o[dt] = (f32x4){0.f, 0.f, 0.f, 0.f};
#pragma unroll
        for (int st = 0; st < 5; ++st) {
            union { bf16x8 v; unsigned u[4]; } pb;
            pb.u[0] = pk2(s[2 * st][0], s[2 * st][1]); pb.u[1] = pk2(s[2 * st][2], s[2 * st][3]); pb.u[2] = pk2(s[2 * st + 1][0], s[2 * st + 1][1]); pb.u[3] = pk2(s[2 * st + 1][2], s[2 * st + 1][3]);
#pragma unroll
            for (int dt = 0; dt < 4; ++dt) {
                const LAS unsigned char* vp = Vt + (16 * (w + 2 * st) + 4 * fq + (fr >> 2)) * AT_STRIDE + (16 * dt + 4 * (fr & 3)) * 2;
                const v4i16_t t0 = __builtin_amdgcn_ds_read_tr16_b64_v4i16((LAS v4i16_t*)vp), t1 = __builtin_amdgcn_ds_read_tr16_b64_v4i16((LAS v4i16_t*)(vp + 16 * AT_STRIDE));
                bf16x8 va; va[0] = t0[0]; va[1] = t0[1]; va[2] = t0[2]; va[3] = t0[3]; va[4] = t1[0]; va[5] = t1[1]; va[6] = t1[2]; va[7] = t1[3];
                o[dt] = __builtin_amdgcn_mfma_f32_16x16x32_bf16(va, pb.v, o[dt], 0, 0, 0); } }
        bf16* op = OMIX + (size_t)(m0 + 16 * w + fr) * DM + 1024 + h * 64 + 4 * fq;
#pragma unroll
        for (int dt = 0; dt < 4; ++dt) { v2u ov; ov.x = pk2(o[dt][0] * inv, o[dt][1] * inv); ov.y = pk2(o[dt][2] * inv, o[dt][3] * inv); *(v2u*)(op + 16 * dt) = ov; }
    }
}
__device__ __forceinline__ void attn_sample_item(const Ctx& C, const Args& a, int item, LAS float* scr  ) {
    const bf16* QKV = (const bf16*)(a.ws + WS_QKV); bf16* OMIX = (bf16*)(a.ws + WS_OMIX);
    const int b = item >> 2, c = item & 3, lane = C.lane; const int mrow = MP + b;
    LAS float* qs = scr; LAS float* ps = scr + 256;
#pragma unroll
    for (int hq = 0; hq < 4; ++hq) qs[hq * 64 + lane] = bf2f(QKV[(size_t)mrow * NQKV + (4 * c + hq) * 64 + lane]);
    LDS_WAIT(); asm volatile("" ::: "memory");
    const float* ck = a.in[I_CK] + ((size_t)b * 128 * 4 + c) * 64; const float* cv = a.in[I_CV] + ((size_t)b * 128 * 4 + c) * 64;
    float* kw = a.out + O_SKWIN + ((size_t)b * 128 * 4 + c) * 64; float* vw = a.out + O_SVWIN + ((size_t)b * 128 * 4 + c) * 64;
#pragma unroll 1
    for (int jj = 0; jj < 3; ++jj) { const int j = jj < 2 ? lane + 64 * jj : 128;
        float d0 = 0.f, d1 = 0.f, d2 = 0.f, d3 = 0.f;
#pragma unroll 4
        for (int d4 = 0; d4 < 16; ++d4) { f32x4 kv;
            if (j < 128) { kv = *(const f32x4*)(ck + (size_t)j * 256 + 4 * d4); if (j >= 1) *(f32x4*)(kw + (size_t)(j - 1) * 256 + 4 * d4) = kv; }
            else { const v2u t = *(const v2u*)(QKV + (size_t)mrow * NQKV + 1024 + c * 64 + 4 * d4); kv = (f32x4){bflo(t.x), bfhi(t.x), bflo(t.y), bfhi(t.y)}; }
            d0 += dot4(kv, *(const LAS f32x4*)(qs + 0 * 64 + 4 * d4)); d1 += dot4(kv, *(const LAS f32x4*)(qs + 1 * 64 + 4 * d4));
            d2 += dot4(kv, *(const LAS f32x4*)(qs + 2 * 64 + 4 * d4)); d3 += dot4(kv, *(const LAS f32x4*)(qs + 3 * 64 + 4 * d4)); }
        if (jj < 2 || lane == 0) { ps[0 * 132 + j] = d0; ps[1 * 132 + j] = d1; ps[2 * 132 + j] = d2; ps[3 * 132 + j] = d3; } }
    LDS_WAIT(); asm volatile("" ::: "memory");
#pragma unroll 1
    for (int hq = 0; hq < 4; ++hq) { const int h = 4 * c + hq;
        const float slope2 = __builtin_amdgcn_exp2f(-0.5f * (float)(h + 1)) * LOG2E, sink2 = a.in[I_SINK][h] * LOG2E;
        const float v0 = lane >= 1 ? ps[hq * 132 + lane] - slope2 * (float)(128 - lane) : -1e30f;
        const float v1 = ps[hq * 132 + 64 + lane] - slope2 * (float)(64 - lane);
        const float v2 = ps[hq * 132 + 128];
        const float mx = wave_max(fmaxf(fmaxf(v0, v1), fmaxf(v2, sink2)));
        const float p0 = __builtin_amdgcn_exp2f(v0 - mx), p1 = __builtin_amdgcn_exp2f(v1 - mx), p2 = __builtin_amdgcn_exp2f(v2 - mx);
        const float tot = wave_sum(p0 + p1) + p2 + __builtin_amdgcn_exp2f(sink2 - mx); const float inv = 1.0f / tot;
        LDS_WAIT(); asm volatile("" ::: "memory");
        ps[hq * 132 + lane] = p0 * inv; ps[hq * 132 + 64 + lane] = p1 * inv; if (lane == 0) ps[hq * 132 + 128] = p2 * inv; }
    LDS_WAIT(); asm volatile("" ::: "memory");
    float o0 = 0.f, o1 = 0.f, o2 = 0.f, o3 = 0.f;
#pragma unroll 4
    for (int j = 0; j < 128; ++j) { const float vv = cv[(size_t)j * 256 + lane]; if (j >= 1) vw[(size_t)(j - 1) * 256 + lane] = vv;
        o0 += ps[0 * 132 + j] * vv; o1 += ps[1 * 132 + j] * vv; o2 += ps[2 * 132 + j] * vv; o3 += ps[3 * 132 + j] * vv; }
    { const float vv = bf2f(QKV[(size_t)mrow * NQKV + 1280 + c * 64 + lane]);
      o0 += ps[0 * 132 + 128] * vv; o1 += ps[1 * 132 + 128] * vv; o2 += ps[2 * 132 + 128] * vv; o3 += ps[3 * 132 + 128] * vv; }
    bf16* op = OMIX + (size_t)mrow * DM + 1024 + (4 * c) * 64 + lane;
    op[0] = (bf16)f2bf(o0); op[64] = (bf16)f2bf(o1); op[128] = (bf16)f2bf(o2); op[192] = (bf16)f2bf(o3);
    LDS_WAIT(); asm volatile("" ::: "memory");
}
__device__ __forceinline__ void phase_mixprep(const Ctx& C, const Args& a) {
    unsigned char* ws = a.ws;
    const float* PRW = (const float*)(ws + WS_PRW); const float* ZROW = (const float*)(ws + WS_CTL) + CW_ZROW;
    for (int unit = blockIdx.x; unit < 256; unit += gridDim.x) attn_prompt_unit(C, a, unit);
    __syncthreads();
    for (int it = C.gw; it < NSAMP * 4; it += C.ngw) attn_sample_item(C, a, it, (LAS float*)(C.lds + C.wave * 16384));
    { bf16* AL = (bf16*)(ws + WS_ALORA); const float* mu = a.in[I_MU] + 3072;
      for (int m = C.gw; m < MPAD; m += C.ngw) {
        const float* prow = PRW + (size_t)m * NRWP + 3072;
        const float* pprev = m < MP ? ((m & 2047) ? prow - NRWP : ZROW) : (m < MV ? a.in[I_SSHIFT] + (size_t)(m - MP) * NRW + 3072 : ZROW);
#pragma unroll
        for (int jj = 0; jj < 6; ++jj) { const int j = C.lane + 64 * jj; float v = 0.f;
            if (j < 288 && m < MV) { const float p = prow[j]; const float u = p + mu[j] * (pprev[j] - p);
                v = j < 64 ? (2.0f * sigmoid_f(2.0f * u) - 1.0f) : (j < 128 ? u : sigmoid_f(u)); }
            AL[(size_t)m * KL + j] = (bf16)f2bf(v); } } }
    for (int r = C.gw; r < NBATCH + NSAMP; r += C.ngw) {
        const float* src = PRW + (size_t)(r < NBATCH ? r * TSEQ + TSEQ - 1 : MP + (r - NBATCH)) * NRWP;
        float* dst = r < NBATCH ? a.out + O_PSHIFT + (size_t)r * NRW : a.out + O_SSHIFT + (size_t)(r - NBATCH) * NRW;
        for (int j = C.lane; j < NRW / 4; j += 64) *((f32x4*)dst + j) = *((const f32x4*)src + j); }
    convert_ffn(C, a.in[I_W2G], a.in[I_W2U], a.in[I_W2D], a.in[I_N2], (bf16*)(ws + WS_W1T), (bf16*)(ws + WS_W2T));
}

constexpr int SC_CH = 16, SC_NCH = TSEQ / SC_CH, SC_OPB = SC_CH * 6 * 64, SC_OPART = SC_CH * 256;
typedef float f32x2 __attribute__((ext_vector_type(2)));
struct StRaw { f32x4 pr, pk, pv, qr, qk, qv, w, a; };
__device__ __forceinline__ void phase_scan(const Ctx& C, const Args& a) {
    unsigned char* ws = a.ws;
    const float* PRW = (const float*)(ws + WS_PRW); const float* ZROW = (const float*)(ws + WS_CTL) + CW_ZROW;
    const float* LWW = (const float*)(ws + WS_LWW); const float* LWA = (const float*)(ws + WS_LWA); float* ORAW = (float*)(ws + WS_ORAW);
    const RwConst rc{a.in[I_MU], a.in[I_KK], a.in[I_KA]};
    LAS float* opb = (LAS float*)C.lds; LAS float* opart = (LAS float*)(C.lds + 2 * SC_OPB * 4);
    const int wave = C.wave, lane = C.lane;
    for (int item = blockIdx.x; item < 256; item += gridDim.x) {
        const int chain = item >> 2, qr = item & 3, b = chain >> 4, h = chain & 15;
        const size_t mbase = (size_t)b * TSEQ;
        const int st_id = (C.tid - 256) & 255, st_t = st_id >> 4, st_kg = lane & 15, hk = h * 64 + 4 * st_kg;
        const f32x4 mr = *(const f32x4*)(rc.mu + hk), mk = *(const f32x4*)(rc.mu + 1024 + hk), mv = *(const f32x4*)(rc.mu + 2048 + hk), kk4 = *(const f32x4*)(rc.k_k + hk), ka4 = *(const f32x4*)(rc.k_a + hk);
        StRaw raw;
        auto st_load = [&](int c) { const int t = c * SC_CH + st_t; const float* prow = PRW + (mbase + t) * NRWP; const float* pp = t ? prow - NRWP : ZROW;
            raw.pr = *(const f32x4*)(prow + hk); raw.pk = *(const f32x4*)(prow + 1024 + hk); raw.pv = *(const f32x4*)(prow + 2048 + hk);
            raw.qr = *(const f32x4*)(pp + hk); raw.qk = *(const f32x4*)(pp + 1024 + hk); raw.qv = *(const f32x4*)(pp + 2048 + hk);
            raw.w = *(const f32x4*)(LWW + (mbase + t) * 1024 + hk); raw.a = *(const f32x4*)(LWA + (mbase + t) * 1024 + hk); };
        auto st_emit = [&](int c) { LAS float* ob = opb + (c & 1) * SC_OPB + st_t * 384 + 4 * st_kg;
            const f32x4 ur = raw.pr + mr * (raw.qr - raw.pr), uk = raw.pk + mk * (raw.qk - raw.pk), uv = raw.pv + mv * (raw.qv - raw.pv);
            const f32x4 kk = uk * kk4; const float n2 = red16(dot4(kk, kk)); const float inv = 1.0f / fmaxf(sqrtf(n2), 1e-12f); const f32x4 kkn = kk * inv;
            const f32x4 aa = sig4(raw.a);
            *(LAS f32x4*)(ob + 0 * 64) = -kkn; *(LAS f32x4*)(ob + 1 * 64) = decay4(raw.w); *(LAS f32x4*)(ob + 2 * 64) = kkn * aa;
            *(LAS f32x4*)(ob + 3 * 64) = uk * (1.0f + (aa - 1.0f) * ka4); *(LAS f32x4*)(ob + 4 * 64) = ur; *(LAS f32x4*)(ob + 5 * 64) = uv; };
        auto st_flush = [&](int c) {
            const LAS float* pp = opart + (c & 1) * SC_OPART + st_id * 4;
#pragma unroll
            for (int i = 0; i < 4; ++i) { const f32x4 p0 = *(const LAS f32x4*)(pp + i * 1024); float s = (p0[0] + p0[1]) + (p0[2] + p0[3]);
                s += dpp_f<0xB1>(s); s += dpp_f<0x4E>(s);
                const int tr = i * 64 + (st_id >> 2);
                if ((st_id & 3) == 0) ORAW[(mbase + c * SC_CH + (tr >> 4)) * 1024 + h * 64 + 16 * qr + (tr & 15)] = s; } };
        const int row_l = lane >> 4, kq = lane & 15, vrow = 16 * qr + 4 * wave + row_l;
        f32x2 S01 = (f32x2){0.f, 0.f}, S23 = (f32x2){0.f, 0.f};
        __syncthreads();
        if (wave < 4) __builtin_amdgcn_s_setprio(3);
        if (wave >= 4) { st_load(0); st_emit(0); st_load(1); }
        __syncthreads();
#pragma unroll 1
        for (int c = 0; c < SC_NCH; ++c) {
            if (wave < 4) {
                const LAS float* ob = opb + (c & 1) * SC_OPB + 4 * kq; const LAS float* vb = opb + (c & 1) * SC_OPB + 320 + vrow;
                LAS float* oo = opart + (c & 1) * SC_OPART + (4 * wave + row_l) * 16 + kq;
                f32x4 na = *(const LAS f32x4*)(ob), w4 = *(const LAS f32x4*)(ob + 64), b4 = *(const LAS f32x4*)(ob + 128), k4 = *(const LAS f32x4*)(ob + 192), r4 = *(const LAS f32x4*)(ob + 256);
                float vv = vb[0];
#pragma unroll
                for (int t = 0; t < SC_CH; ++t) { const LAS float* p = ob + (t + 1) * 384;
                    f32x4 na_n, w4_n, b4_n, k4_n, r4_n; float vv_n;
                    if (t + 1 < SC_CH) { na_n = *(const LAS f32x4*)(p); w4_n = *(const LAS f32x4*)(p + 64); b4_n = *(const LAS f32x4*)(p + 128); k4_n = *(const LAS f32x4*)(p + 192); r4_n = *(const LAS f32x4*)(p + 256); vv_n = vb[(t + 1) * 384]; }
                    f32x2 d = S01 * (f32x2){na[0], na[1]}; d = S23 * (f32x2){na[2], na[3]} + d;
                    const float sa = red16(d[0] + d[1]);
                    const f32x2 vk01 = (f32x2){k4[0], k4[1]} * vv, vk23 = (f32x2){k4[2], k4[3]} * vv;
                    const f32x2 t01 = (f32x2){b4[0], b4[1]} * sa + vk01, t23 = (f32x2){b4[2], b4[3]} * sa + vk23;
                    S01 = S01 * (f32x2){w4[0], w4[1]} + t01; S23 = S23 * (f32x2){w4[2], w4[3]} + t23;
                    f32x2 e = S01 * (f32x2){r4[0], r4[1]}; e = S23 * (f32x2){r4[2], r4[3]} + e;
                    oo[t * 256] = e[0] + e[1];
                    if (t + 1 < SC_CH) { na = na_n; w4 = w4_n; b4 = b4_n; k4 = k4_n; r4 = r4_n; vv = vv_n; } }
            } else {
                if (c + 1 < SC_NCH) { st_emit(c + 1); if (c + 2 < SC_NCH) st_load(c + 2); }
                if (c >= 1) st_flush(c - 1);
            }
            __syncthreads();
        }
        if (wave >= 4) st_flush(SC_NCH - 1);
        __builtin_amdgcn_s_setprio(0);
        if (wave < 4) { float* sp = a.out + O_PWKV + ((size_t)(b * 16 + h) * 64 + vrow) * 64 + 4 * kq; *(f32x4*)sp = (f32x4){S01[0], S01[1], S23[0], S23[1]}; }
    }
    __syncthreads();
    { LAS float* vs = (LAS float*)(C.lds + wave * 16384);
      for (int it = C.gw; it < NSAMP * 16; it += C.ngw) { const int bs = it >> 4, hs = it & 15, kg = lane & 15, v_l = lane >> 4, hk = hs * 64 + 4 * kg; const size_t m = MP + bs;
        Ops o; prep_ops<true>(o, PRW + m * NRWP, a.in[I_SSHIFT] + (size_t)bs * NRW, LWW + m * 1024, LWA + m * 1024, rc, hk);
        if (v_l == 0) *(LAS f32x4*)(vs + 4 * kg) = o.v;
        LDS_WAIT(); asm volatile("" ::: "memory");
        const float* s0 = a.in[I_SWKV] + (size_t)(bs * 16 + hs) * 4096; float* s1 = a.out + O_SWKV + (size_t)(bs * 16 + hs) * 4096;
#pragma unroll 4
        for (int i = 0; i < 16; ++i) { const int row = 4 * i + v_l; const f32x4 S4 = *(const f32x4*)(s0 + row * 64 + 4 * kg);
            const float sa = red16(dot4(S4, o.na)); const float vv = vs[row];
            const f32x4 Sn = S4 * o.w + (o.b * sa + o.kp * vv);
            *(f32x4*)(s1 + row * 64 + 4 * kg) = Sn;
            const float ov = red16(dot4(Sn, o.r));
            if (kg == 0) ORAW[m * 1024 + hs * 64 + row] = ov; }
        LDS_WAIT(); asm volatile("" ::: "memory"); } }
}

__device__ __forceinline__ void phase_post(const Ctx& C, const Args& a) {
    unsigned char* ws = a.ws;
    const float* PRW = (const float*)(ws + WS_PRW); const float* ZROW = (const float*)(ws + WS_CTL) + CW_ZROW; const float* LWA = (const float*)(ws + WS_LWA);
    const bf16* LWG = (const bf16*)(ws + WS_LWG); const float* ORAW = (const float*)(ws + WS_ORAW); bf16* OMIX = (bf16*)(ws + WS_OMIX);
    const RwConst rc{a.in[I_MU], a.in[I_KK], a.in[I_KA]};
    const int kg = C.lane & 15;
    for (int g = C.gw * 4 + (C.lane >> 4); g < MV * 16; g += C.ngw * 4) { const int m = g >> 4, h = g & 15, hk = h * 64 + 4 * kg;
        const float* prow = PRW + (size_t)m * NRWP; const float* pprev = m < MP ? ((m & 2047) ? prow - NRWP : ZROW) : a.in[I_SSHIFT] + (size_t)(m - MP) * NRW;
        Ops o; prep_ops<false>(o, prow, pprev, nullptr, LWA + (size_t)m * 1024, rc, hk);
        const f32x4 rk = *(const f32x4*)(a.in[I_RK] + hk);
        const float sb = red16(dot4(o.r * o.kp, rk));
        const f32x4 o4 = *(const f32x4*)(ORAW + (size_t)m * 1024 + hk);
        const float mean = red16((o4[0] + o4[1]) + (o4[2] + o4[3])) * (1.0f / 64.0f); const f32x4 d = o4 - mean;
        const float var = red16(dot4(d, d)) * (1.0f / 64.0f); const float rstd = 1.0f / sqrtf(var + 64e-5f);
        const f32x4 lg = *(const f32x4*)(a.in[I_LNG] + hk), lb = *(const f32x4*)(a.in[I_LNB] + hk);
        const v2u gw2 = *(const v2u*)(LWG + (size_t)m * 1024 + hk); const f32x4 g4 = (f32x4){bflo(gw2.x), bfhi(gw2.x), bflo(gw2.y), bfhi(gw2.y)};
        const f32x4 res = (d * rstd * lg + lb + o.v * sb) * g4;
        v2u ov; ov.x = pk2(res[0], res[1]); ov.y = pk2(res[2], res[3]); *(v2u*)(OMIX + (size_t)m * DM + hk) = ov; }
}
__device__ __forceinline__ void phase_reduce(const Ctx& C, const Args& a, int nsl, const float* xin_s, float scale, float* ssq) {
    const float* slab = (const float*)(a.ws + WS_PRW); bf16* XB = (bf16*)(a.ws + WS_XB);
    for (int it = C.gw; it < NSAMP * 8; it += C.ngw) { const int r = it >> 3, col = (it & 7) * 256 + 4 * C.lane;
        f32x4 s = (f32x4){0.f, 0.f, 0.f, 0.f};
        for (int sl = 0; sl < nsl; ++sl) s += *(const f32x4*)(slab + ((size_t)sl * 128 + r) * DM + col);
        const f32x4 x = *(const f32x4*)(xin_s + (size_t)r * DM + col) + s * scale;
        *(f32x4*)(a.out + (size_t)(MP + r) * DM + col) = x;
        v2u o; o.x = pk2(x[0], x[1]); o.y = pk2(x[2], x[3]); *(v2u*)(XB + (size_t)(MP + r) * DM + col) = o;
        const float ss = wave_sum(dot4(x, x)); if (C.lane == 0) atomicAdd(ssq + MP + r, ss); }
}
__device__ __forceinline__ void phase_final(const Ctx& C, const Args& a, int nsl) {
    const float* ss4 = (const float*)(a.ws + WS_CTL) + CW_SS + 3 * SS_STRIDE; const float* gf = a.in[I_NF];
    for (int m = C.gw; m < MP; m += C.ngw) { const float rs = 1.0f / sqrtf(ss4[m] * (1.0f / 2048.0f) + 1e-6f); f32x4* xr = (f32x4*)(a.out + (size_t)m * DM);
#pragma unroll
        for (int j = 0; j < 8; ++j) { const f32x4 v = xr[C.lane + 64 * j], g = *((const f32x4*)gf + C.lane + 64 * j); xr[C.lane + 64 * j] = v * rs * g; } }
    const float* slab = (const float*)(a.ws + WS_PRW); LAS float* red = (LAS float*)C.lds;
    for (int r = blockIdx.x; r < NSAMP; r += gridDim.x) { const int col = 4 * C.tid;
        f32x4 s = (f32x4){0.f, 0.f, 0.f, 0.f};
        for (int sl = 0; sl < nsl; ++sl) s += *(const f32x4*)(slab + ((size_t)sl * 128 + r) * DM + col);
        f32x4* xp = (f32x4*)(a.out + (size_t)(MP + r) * DM + col); const f32x4 x = *xp + s * 0.5f;
        const float ws_ = wave_sum(dot4(x, x));
        __syncthreads(); if (C.lane == 0) red[C.wave] = ws_; __syncthreads();
        float tot = 0.f;
#pragma unroll
        for (int w = 0; w < NWAVES; ++w) tot += red[w];
        const float rs = 1.0f / sqrtf(tot * (1.0f / 2048.0f) + 1e-6f);
        *xp = x * rs * *(const f32x4*)(gf + col); }
}
__global__ void __launch_bounds__(NWAVES * 64, 2) mk_fwd(Args a_kernarg) {
    const Args& a = *(const Args*)__builtin_amdgcn_kernarg_segment_ptr();
    extern __shared__ __attribute__((aligned(16))) unsigned char lds_raw[];
    Ctx C; C.lds = (LAS unsigned char*)lds_raw; C.tid = threadIdx.x; C.lane = C.tid & 63; C.wave = __builtin_amdgcn_readfirstlane(C.tid >> 6);
    const int G = gridDim.x, bx = blockIdx.x, vcu = (G % 8 == 0) ? (bx % 8) * (G / 8) + bx / 8 : bx;
    C.gw = vcu * NWAVES + C.wave; C.ngw = G * NWAVES;
    volatile LAS unsigned* MISC = (volatile LAS unsigned*)(C.lds + MISC_OFF);
    for (int u = C.tid; u < (LDS_BYTES - LDSCTL_OFF) / 4; u += NWAVES * 64) ((LAS unsigned*)(C.lds + LDSCTL_OFF))[u] = 0u;
    __syncthreads();
    unsigned char* ws = a.ws; unsigned* ctl = (unsigned*)(ws + WS_CTL);
    const int lo = a.ph_lo, hi = a.ph_hi;
    XcdBarrier bar; bar.bar = ctl + CW_BAR; bar.x = 0; bar.st = nullptr;
    if (hi - lo > 1) bar = xcd_barrier_post(ctl + CW_BAR, MISC + 8);
#ifndef PH_MASK
#define PH_MASK 0x3FFF
#endif
#define IN(k) (((PH_MASK >> (k)) & 1) && lo <= (k) && (k) < hi)
#define SEAM(k) do { if (IN(k) && IN((k) + 1)) xcd_barrier(bar); } while (0)
#ifndef DUP_MASK
#define DUP_MASK 0
#endif
#define DUP(k) (((DUP_MASK >> (k)) & 1) != 0)
    float* ssb = (float*)ctl + CW_SS;
    bf16* XB = (bf16*)(ws + WS_XB); bf16* HB = (bf16*)(ws + WS_H); bf16* OMIX = (bf16*)(ws + WS_OMIX);
    LAS unsigned char* ring = C.lds;

    if (IN(0)) { for (int rep = 0; rep < (DUP(0) ? 2 : 1); ++rep) { if (rep) xcd_barrier(bar); phase_prologue(C, a); } SEAM(0); }
    if (IN(1)) {
        pg8::Gemm g{XB, (const bf16*)(ws + WS_W1T), MPAD, 2 * FF, DM}; pg8::StaticOrder S; S.init(MPAD, 2 * FF, DM, G, bx);
        pg8::EpiSwiglu E{HB, ssb, FF};
        pg8::gemm_phase<pg8::EpiSwiglu, pg8::StaticOrder, true, true>(ring, g, S, E); SEAM(1); }
    if (IN(2)) {
        pg8::Gemm g{HB, (const bf16*)(ws + WS_W2T), MPAD, DM, FF}; pg8::SliceOrder S; S.init(FF, G, bx);
        pg8::EpiResid E{a.in[I_XP], a.out, XB, ssb + SS_STRIDE, 0.5f, (float*)(ws + WS_PRW)};
        pg8::gemm_phase<pg8::EpiResid, pg8::SliceOrder, true, true>(ring, g, S, E); SEAM(2); }
    if (IN(3)) { phase_reduce(C, a, FF / 256, a.in[I_XS], 0.5f, ssb + SS_STRIDE); SEAM(3); }
    if (IN(4)) {
        pg8::Gemm g{XB, (const bf16*)(ws + WS_WINT), MPAD, NIN, DM}; pg8::StaticOrder S; S.init(MPAD, NIN, DM, G, bx);
        pg8::EpiWin E{(bf16*)(ws + WS_QKV), (float*)(ws + WS_PRW), ssb + SS_STRIDE, a.out + O_PKWIN, (long)(O_SKWIN - O_PKWIN), QSCALE};
        pg8::gemm_phase<pg8::EpiWin, pg8::StaticOrder, true, true>(ring, g, S, E); SEAM(4); }
    if (IN(5)) { phase_mixprep(C, a); SEAM(5); }
    if (IN(6)) {
        pg8::Gemm g{(const bf16*)(ws + WS_ALORA), (const bf16*)(ws + WS_WLT), MPAD, NL, KL}; pg8::StaticOrder S; S.init(MPAD, NL, KL, G, bx);
        pg8::EpiLora E{(float*)(ws + WS_LWW), (long)((WS_LWA - WS_LWW) / 4), (bf16*)(ws + WS_LWG), a.in[I_DBASE], (long)(a.in[I_IBASE] - a.in[I_DBASE])};
        pg8::gemm_phase<pg8::EpiLora, pg8::StaticOrder, true, true>(ring, g, S, E); SEAM(6); }
    if (IN(7)) { for (int rep = 0; rep < (DUP(7) ? 2 : 1); ++rep) { if (rep) xcd_barrier(bar); phase_scan(C, a); } SEAM(7); }
    if (IN(8)) { for (int rep = 0; rep < (DUP(8) ? 2 : 1); ++rep) { if (rep) xcd_barrier(bar); phase_post(C, a); } SEAM(8); }
    if (IN(9)) {
        pg8::Gemm g{OMIX, (const bf16*)(ws + WS_WOUTT), MPAD, DM, DM}; pg8::SliceOrder S; S.init(DM, G, bx);
        pg8::EpiResid E{a.out, a.out, XB, ssb + 2 * SS_STRIDE, 1.0f, (float*)(ws + WS_PRW)};
        pg8::gemm_phase<pg8::EpiResid, pg8::SliceOrder, true, true>(ring, g, S, E); SEAM(9); }
    if (IN(10)) { phase_reduce(C, a, DM / 256, a.out + (size_t)MP * DM, 1.0f, ssb + 2 * SS_STRIDE); SEAM(10); }
    if (IN(11)) {
        pg8::Gemm g{XB, (const bf16*)(ws + WS_W1T), MPAD, 2 * FF, DM}; pg8::StaticOrder S; S.init(MPAD, 2 * FF, DM, G, bx);
        pg8::EpiSwiglu E{HB, ssb + 2 * SS_STRIDE, FF};
        pg8::gemm_phase<pg8::EpiSwiglu, pg8::StaticOrder, true, true>(ring, g, S, E); SEAM(11); }
    if (IN(12)) {
        pg8::Gemm g{HB, (const bf16*)(ws + WS_W2T), MPAD, DM, FF}; pg8::SliceOrder S; S.init(FF, G, bx);
        pg8::EpiResid E{a.out, a.out, nullptr, ssb + 3 * SS_STRIDE, 0.5f, (float*)(ws + WS_PRW)};
        pg8::gemm_phase<pg8::EpiResid, pg8::SliceOrder, true, true>(ring, g, S, E); SEAM(12); }
    if (IN(13)) { phase_final(C, a, FF / 256); }
#undef IN
#undef SEAM
}

extern "C" void kernel_launch(void* const* d_in, const int* in_sizes, int n_in, void* d_out, int out_size, void* d_ws, size_t ws_size, hipStream_t stream) {
    static int grid = 0;
    if (grid == 0) {
        if (n_in != 30 || out_size != (int)O_END || ws_size < WS_END) { fprintf(stderr, "kernel_launch: unexpected shapes: n_in %d out %d ws %zu (need %zu)\n", n_in, out_size, ws_size, (size_t)WS_END); grid = -1; return; }
        int dev = 0, cus = 0;
        if (hipGetDevice(&dev) != hipSuccess || hipDeviceGetAttribute(&cus, hipDeviceAttributeMultiprocessorCount, dev) != hipSuccess) { grid = -1; return; }
        if (hipFuncSetAttribute((const void*)mk_fwd, hipFuncAttributeMaxDynamicSharedMemorySize, LDS_BYTES) != hipSuccess) { fprintf(stderr, "kernel_launch: hipFuncSetAttribute failed\n"); grid = -1; return; }
        int per_cu = 0;
        if (hipOccupancyMaxActiveBlocksPerMultiprocessor(&per_cu, (const void*)mk_fwd, NWAVES * 64, LDS_BYTES) != hipSuccess || per_cu < 1) fprintf(stderr, "kernel_launch: occupancy query says %d\n", per_cu);
        (void)hipGetLastError();
        grid = cus;
    }
    if (grid < 0) return;
    if (hipMemsetAsync((char*)d_ws + WS_CTL, 0, CTL_ZERO_BYTES, stream) != hipSuccess) { fprintf(stderr, "kernel_launch: memset failed\n"); return; }
    Args a{};
    for (int i = 0; i < 30; ++i) a.in[i] = (const float*)d_in[i];
    a.out = (float*)d_out; a.ws = (unsigned char*)d_ws;
    if (MK_N_LAUNCHES == 1) { a.ph_lo = 0; a.ph_hi = N_PHASES; hipLaunchKernelGGL(mk_fwd, dim3(grid), dim3(NWAVES * 64), LDS_BYTES, stream, a); }
    else for (int p = 0; p < N_PHASES; ++p) { a.ph_lo = p; a.ph_hi = p + 1; hipLaunchKernelGGL(mk_fwd, dim3(grid), dim3(NWAVES * 64), LDS_BYTES, stream, a); }
    const hipError_t le = hipPeekAtLastError();
    if (le != hipSuccess) fprintf(stderr, "kernel_launch: launch failed: %s\n", hipGetErrorName(le));
}
```

```cpp
#include <hip/hip_runtime.h>
#include <cstdio>
#include <cstdint>
#define MK_N_LAUNCHES 1
namespace pg8 {
#define PG8_LAS __attribute__((address_space(3)))
typedef unsigned short bf16_t;
typedef short bf16x8 __attribute__((ext_vector_type(8)));
typedef float f32x4 __attribute__((ext_vector_type(4)));
typedef unsigned u32x4 __attribute__((ext_vector_type(4)));
constexpr int BM = 256, BK = 64, HALF = 128, HTB = HALF * BK * 2  , STAGE_BYTES = 8 * HTB, NXCD = 8, WGM = 8;

__host__ __device__ __forceinline__ int lds_byte(int r, int c) { const int st = (r >> 4) * 2 + (c >> 5), rr = r & 15, cc = c & 31, ob = rr * 64 + cc * 2; return st * 1024 + (ob ^ (((ob >> 9) & 1) << 5)); }
__host__ __device__ __forceinline__ void stage_rc(int b, int& R, int& C) { const int st = b / 1024, sb = b % 1024, swz = sb ^ (((sb >> 9) & 1) << 5); R = (st >> 1) * 16 + swz / 64; C = (st & 1) * 32 + (swz % 64) / 2; }
__host__ __device__ __forceinline__ int perm32(int rho) { const int n = rho >> 4, i = rho & 15; return 8 * (i >> 2) + 4 * n + (i & 3); }

struct Unit { int pm, pn, k0, nt, kind; };
struct Gemm { const bf16_t* A; const bf16_t* Bt; int M, N, K; };

struct StaticOrder {
    int nM, nN, nwg, G, c, ntf;
    __host__ __device__ void init(int M, int N, int K, int G_, int c_) { nM = M / BM; nN = N / BM; nwg = nM * nN; G = G_; c = c_; ntf = K / BK; }
    __host__ __device__ bool next(int i, Unit& u) const {
        const long L = (long)i * G + c; if (L >= nwg) return false;
        int wgid = (int)L; { const int q = nwg / NXCD, r = nwg % NXCD, xcd = wgid % NXCD, off = wgid / NXCD; wgid = (xcd < r ? xcd * (q + 1) : r * (q + 1) + (xcd - r) * q) + off; }
        const int nig = WGM * nN, gid = wgid / nig, fm = gid * WGM, gsz = (nM - fm) < WGM ? (nM - fm) : WGM;
        u.pm = fm + ((wgid % nig) % gsz); u.pn = (wgid % nig) / gsz; u.k0 = 0; u.nt = ntf; u.kind = 0; return true;
    }
    __device__ __forceinline__ void a_ready(const Unit&) const {}
    __device__ __forceinline__ void done(const Unit&) const {}
};
struct DupOrder : StaticOrder { int rep; __host__ __device__ bool next(int i, Unit& u) const { return StaticOrder::next(i / rep, u); } };
struct SliceOrder : StaticOrder {
    int nsl;
    __host__ __device__ void init(int K, int G_, int c_) { StaticOrder::init(8192, 2048, K, G_, c_); nsl = ntf / 4; }
    __host__ __device__ bool next(int i, Unit& u) const {
        const long L = (long)i * G + c;
        if (L < nwg) return StaticOrder::next(i, u);
        const int j = (int)(L - nwg); if (j >= 8 * nsl) return false;
        const int sl = j >> 3; u.pm = 32; u.pn = j & 7; u.k0 = 4 * sl; u.nt = (sl == nsl - 1) ? ntf - 4 * sl : 4; u.kind = 1; return true;
    }
};

__device__ __forceinline__ unsigned cvt_pk_bf16(float lo, float hi) { unsigned r; asm volatile("v_cvt_pk_bf16_f32 %0, %1, %2" : "=v"(r) : "v"(lo), "v"(hi)); return r; }
typedef unsigned u32x2 __attribute__((ext_vector_type(2)));
constexpr int MVALID = 8320, MPROMPT = 8192, DMODEL = 2048;
__device__ __forceinline__ float rs_row(const float* ss, int row) { return __builtin_amdgcn_rsqf(ss[row] * (1.0f / 2048.0f) + 1e-6f); }
__device__ __forceinline__ float silu_mul(float g, float u) { return g * u * __builtin_amdgcn_rcpf(1.0f + __builtin_amdgcn_exp2f(-1.4426950408889634f * g)); }
__device__ __forceinline__ float sigmoid_f(float x) { return __builtin_amdgcn_rcpf(1.0f + __builtin_amdgcn_exp2f(-1.4426950408889634f * x)); }

struct EpiSwiglu {
    static constexpr bool PERM = true, AFTER_DRAIN = false;
    bf16_t* H; const float* ss; int ldh;
    __device__ __forceinline__ void operator()(const f32x4 (&acc)[2][2][4][2], const Unit& u, int wr, int wc, int fr, int fq) const {
        const int row0 = u.pm * BM + wr * 64 + fr, col0 = u.pn * HALF + wc * 32 + 8 * fq;
#pragma unroll
        for (int ai = 0; ai < 2; ++ai)
#pragma unroll
            for (int m = 0; m < 4; ++m) { const int row = row0 + ai * HALF + m * 16; const float rs = rs_row(ss, row);
                const f32x4 g0 = acc[ai][0][m][0] * rs, g1 = acc[ai][0][m][1] * rs, u0 = acc[ai][1][m][0] * rs, u1 = acc[ai][1][m][1] * rs;
                u32x4 w; w.x = cvt_pk_bf16(silu_mul(g0[0], u0[0]), silu_mul(g0[1], u0[1])); w.y = cvt_pk_bf16(silu_mul(g0[2], u0[2]), silu_mul(g0[3], u0[3]));
                w.z = cvt_pk_bf16(silu_mul(g1[0], u1[0]), silu_mul(g1[1], u1[1])); w.w = cvt_pk_bf16(silu_mul(g1[2], u1[2]), silu_mul(g1[3], u1[3]));
                *(u32x4*)(H + (size_t)row * ldh + col0) = w; }
    }
};
struct EpiResid {
    static constexpr bool PERM = true, AFTER_DRAIN = false;
    const float* xin; float* xout; bf16_t* xb; float* ssq; float scale; float* slab;
    __device__ __forceinline__ void operator()(const f32x4 (&acc)[2][2][4][2], const Unit& u, int wr, int wc, int fr, int fq) const {
        const int col0 = u.pn * BM + wc * 32 + 8 * fq;
        if (u.kind == 0) {
            const int row0 = u.pm * BM + wr * 64 + fr;
#pragma unroll
            for (int ai = 0; ai < 2; ++ai)
#pragma unroll
                for (int m = 0; m < 4; ++m) { const int row = row0 + ai * HALF + m * 16; const size_t off = (size_t)row * DMODEL + col0;
                    float part = 0.f;
#pragma unroll
                    for (int bj = 0; bj < 2; ++bj) { const f32x4 x0 = *(const f32x4*)(xin + off + bj * HALF), x1 = *(const f32x4*)(xin + off + bj * HALF + 4);
                        const f32x4 v0 = x0 + acc[ai][bj][m][0] * scale, v1 = x1 + acc[ai][bj][m][1] * scale;
                        part += (v0[0] * v0[0] + v0[1] * v0[1]) + (v0[2] * v0[2] + v0[3] * v0[3]) + (v1[0] * v1[0] + v1[1] * v1[1]) + (v1[2] * v1[2] + v1[3] * v1[3]);
                        *(f32x4*)(xout + off + bj * HALF) = v0; *(f32x4*)(xout + off + bj * HALF + 4) = v1;
                        if (xb) { u32x4 w; w.x = cvt_pk_bf16(v0[0], v0[1]); w.y = cvt_pk_bf16(v0[2], v0[3]); w.z = cvt_pk_bf16(v1[0], v1[1]); w.w = cvt_pk_bf16(v1[2], v1[3]);
                            *(u32x4*)(xb + off + bj * HALF) = w; } }
                    part += __shfl_xor(part, 16); part += __shfl_xor(part, 32);
                    if (fq == 0) atomicAdd(ssq + row, part); }
        } else {
            float* sb = slab + ((size_t)(u.k0 >> 2) * 128 + wr * 64 + fr) * DMODEL + col0;
#pragma unroll
            for (int m = 0; m < 4; ++m)
#pragma unroll
                for (int bj = 0; bj < 2; ++bj) { float* o = sb + (size_t)(m * 16) * DMODEL + bj * HALF; *(f32x4*)o = acc[0][bj][m][0]; *(f32x4*)(o + 4) = acc[0][bj][m][1]; }
        }
    }
};
struct EpiWin {
    static constexpr bool PERM = true, AFTER_DRAIN = false;
    bf16_t* QKV; float* PRW; const float* ss; float* kwin_p; long wins_minus_winp; float qscale;
    __device__ __forceinline__ void operator()(const f32x4 (&acc)[2][2][4][2], const Unit& u, int wr, int wc, int fr, int fq) const {
        const int row0 = u.pm * BM + wr * 64 + fr, c0 = wc * 32 + 8 * fq;
#pragma unroll
        for (int ai = 0; ai < 2; ++ai)
#pragma unroll
            for (int m = 0; m < 4; ++m) { const int row = row0 + ai * HALF + m * 16; const float rs = rs_row(ss, row);
#pragma unroll
                for (int bj = 0; bj < 2; ++bj) { const f32x4 v0 = acc[ai][bj][m][0] * rs, v1 = acc[ai][bj][m][1] * rs; const int c256 = bj * HALF + c0;
                    if (u.pn < 6) { const float sc = u.pn < 4 ? qscale : 1.0f;
                        u32x4 w; w.x = cvt_pk_bf16(v0[0] * sc, v0[1] * sc); w.y = cvt_pk_bf16(v0[2] * sc, v0[3] * sc); w.z = cvt_pk_bf16(v1[0] * sc, v1[1] * sc); w.w = cvt_pk_bf16(v1[2] * sc, v1[3] * sc);
                        *(u32x4*)(QKV + (size_t)row * 1536 + u.pn * BM + c256) = w;
                        if (u.pn >= 4) { long off = -1; const bool isp = row < MPROMPT; const long kv = u.pn - 4;
                            if (isp) { const int t = row & 2047; if (t >= 1920) off = kv * 131072 + (long)((row >> 11) * 128 + (t - 1920)) * 256 + c256; }
                            else if (row < MVALID) off = (long)(wins_minus_winp) + kv * 4194304 + (long)((row - MPROMPT) * 128 + 127) * 256 + c256;
                            if (off >= 0) { *(f32x4*)(kwin_p + off) = v0; *(f32x4*)(kwin_p + off + 4) = v1; } }
                    } else { float* o = PRW + (size_t)row * 3584 + (u.pn - 6) * BM + c256; *(f32x4*)o = v0; *(f32x4*)(o + 4) = v1; } } }
    }
};
struct EpiLora {
    static constexpr bool PERM = true, AFTER_DRAIN = false;
    float* LWW; long lwa_minus_lww; bf16_t* LWG; const float* dbase; long ibase_minus_dbase;
    __device__ __forceinline__ void operator()(const f32x4 (&acc)[2][2][4][2], const Unit& u, int wr, int wc, int fr, int fq) const {
        const int row0 = u.pm * BM + wr * 64 + fr, seg = u.pn >> 2, cb = (u.pn & 3) * BM + wc * 32 + 8 * fq;
#pragma unroll
        for (int bj = 0; bj < 2; ++bj) { const int col = cb + bj * HALF;
            f32x4 b0 = (f32x4){0.f, 0.f, 0.f, 0.f}, b1 = b0;
            if (seg < 2) { const float* bp = dbase + (seg ? ibase_minus_dbase : 0) + col; b0 = *(const f32x4*)bp; b1 = *(const f32x4*)(bp + 4); }
#pragma unroll
            for (int ai = 0; ai < 2; ++ai)
#pragma unroll
                for (int m = 0; m < 4; ++m) { const int row = row0 + ai * HALF + m * 16; const f32x4 v0 = acc[ai][bj][m][0] + b0, v1 = acc[ai][bj][m][1] + b1;
                    if (seg == 2) { u32x4 w; w.x = cvt_pk_bf16(v0[0], v0[1]); w.y = cvt_pk_bf16(v0[2], v0[3]); w.z = cvt_pk_bf16(v1[0], v1[1]); w.w = cvt_pk_bf16(v1[2], v1[3]);
                        *(u32x4*)(LWG + (size_t)row * 1024 + col) = w; }
                    else { float* o = LWW + (seg ? lwa_minus_lww : 0) + (size_t)row * 1024 + col; *(f32x4*)o = v0; *(f32x4*)(o + 4) = v1; } } }
    }
};
template <class Epi, class Sched, bool ALIGN_EPI = false, bool SP2 = false>
__device__ __forceinline__ void gemm_phase(PG8_LAS unsigned char* lds, const Gemm g, const Sched& S, const Epi& E) {
    const int tid = threadIdx.x, wid = __builtin_amdgcn_readfirstlane(tid >> 6), lane = tid & 63, wr = wid >> 2, wc = wid & 3, fr = lane & 15, fq = lane >> 4;
    const int K = g.K;
    unsigned voffA[2], voffB[2];
#pragma unroll
    for (int i = 0; i < 2; ++i) { int R, C; stage_rc(tid * 16 + i * 8192, R, C); const int Rb = Epi::PERM ? ((R & ~31) + perm32(R & 31)) : R;
        voffA[i] = (unsigned)(R * K + C) * 2u; voffB[i] = (unsigned)(Rb * K + C) * 2u; }
    const size_t kstep = (size_t)(BK * 2);
    const size_t hstep = (size_t)HALF * K * 2;
    const size_t tstep = 2 * hstep;
    const unsigned ldsw = (unsigned)wid * 1024u;
    const int aoff = lds_byte(wr * 64 + fr, fq * 8), boff = lds_byte(wc * 32 + fr, fq * 8);
#define PG8_SA(b, h) (((b) * 2 + (h)) * HTB)
#define PG8_SB(b, h) ((4 + (b) * 2 + (h)) * HTB)
#define PG8_STAGE(bufoff, gbase, voff) do { _Pragma("unroll") for (int _i = 0; _i < 2; ++_i) \
        __builtin_amdgcn_global_load_lds((const unsigned*)((const char*)(gbase) + (voff)[_i]), (PG8_LAS unsigned*)(lds + (bufoff) + ldsw + _i * 8192), 16, 0, 0); } while (0)
#define PG8_LDA(dst, b, h) do { _Pragma("unroll") for (int m = 0; m < 4; ++m) _Pragma("unroll") for (int k = 0; k < 2; ++k) dst[m][k] = *(const PG8_LAS bf16x8*)(lds + PG8_SA(b, h) + aoff + m * 2048 + k * 1024); } while (0)
#define PG8_LDB(dst, b, h) do { _Pragma("unroll") for (int n = 0; n < 2; ++n) _Pragma("unroll") for (int k = 0; k < 2; ++k) dst[n][k] = *(const PG8_LAS bf16x8*)(lds + PG8_SB(b, h) + boff + n * 2048 + k * 1024); } while (0)
#define PG8_MMA(ai, bj, At, Bt) do { __builtin_amdgcn_s_setprio(1); _Pragma("unroll") for (int m = 0; m < 4; ++m) _Pragma("unroll") for (int n = 0; n < 2; ++n) _Pragma("unroll") for (int k = 0; k < 2; ++k) \
        acc[ai][bj][m][n] = __builtin_amdgcn_mfma_f32_16x16x32_bf16(Bt[n][k], At[m][k], acc[ai][bj][m][n], 0, 0, 0); __builtin_amdgcn_s_setprio(0); } while (0)
#define PG8_WAIT_V(n) asm volatile("s_waitcnt vmcnt(" #n ")" ::: "memory")
#define PG8_WAIT_L(n) asm volatile("s_waitcnt lgkmcnt(" #n ")" ::: "memory")
#define PG8_BAR __builtin_amdgcn_s_barrier()
#define PG8_SCHED __builtin_amdgcn_sched_barrier(0)
    Unit cur, nxt; int ui = 0;
    if (!S.next(0, cur)) return;
    f32x4 acc[2][2][4][2];
#pragma unroll
    for (int a = 0; a < 2; ++a)
#pragma unroll
        for (int b = 0; b < 2; ++b)
#pragma unroll
            for (int m = 0; m < 4; ++m)
#pragma unroll
                for (int n = 0; n < 2; ++n) acc[a][b][m][n] = (f32x4){0.f, 0.f, 0.f, 0.f};
    bf16x8 At[4][2], B0[2][2], B1[2][2];
    const char* cA = (const char*)g.A + (size_t)cur.pm * tstep + (size_t)cur.k0 * kstep; const char* cB = (const char*)g.Bt + (size_t)cur.pn * tstep + (size_t)cur.k0 * kstep;
    S.a_ready(cur);
    if constexpr (SP2) {
        PG8_STAGE(PG8_SB(0, 0), cB, voffB); PG8_STAGE(PG8_SB(0, 1), cB + hstep, voffB); PG8_STAGE(PG8_SA(0, 0), cA, voffA); PG8_STAGE(PG8_SA(0, 1), cA + hstep, voffA);
        if (wr == 1) PG8_BAR;
        PG8_WAIT_V(2); PG8_BAR;
        PG8_STAGE(PG8_SB(1, 0), cB + kstep, voffB); PG8_STAGE(PG8_SA(1, 0), cA + kstep, voffA); PG8_STAGE(PG8_SB(1, 1), cB + hstep + kstep, voffB);
        PG8_WAIT_V(6); PG8_BAR;
    } else {
        PG8_STAGE(PG8_SB(0, 0), cB, voffB); PG8_STAGE(PG8_SA(0, 0), cA, voffA); PG8_STAGE(PG8_SB(0, 1), cB + hstep, voffB); PG8_STAGE(PG8_SA(0, 1), cA + hstep, voffA);
        if (wr == 1) PG8_BAR;
        PG8_WAIT_V(4); PG8_BAR;
        PG8_STAGE(PG8_SB(1, 0), cB + kstep, voffB); PG8_STAGE(PG8_SA(1, 0), cA + kstep, voffA); PG8_STAGE(PG8_SB(1, 1), cB + hstep + kstep, voffB);
        PG8_WAIT_V(6); PG8_BAR;
    }
    for (;;) {
        const bool has_next = S.next(ui + 1, nxt);
        const char* nA = has_next ? (const char*)g.A + (size_t)nxt.pm * tstep + (size_t)nxt.k0 * kstep : cA; const char* nB = has_next ? (const char*)g.Bt + (size_t)nxt.pn * tstep + (size_t)nxt.k0 * kstep : cB;
        const int nt = cur.nt;
#pragma unroll 1
        for (int t = 0; t < nt; t += 2) {
            const bool last = (t == nt - 2);
            const char* a1 = cA + (size_t)(t + 1) * kstep;
            const char* a2 = last ? nA : cA + (size_t)(t + 2) * kstep; const char* b2 = last ? nB : cB + (size_t)(t + 2) * kstep;
            const char* a3 = a2 + kstep; const char* b3 = b2 + kstep;
            if (last && has_next) S.a_ready(nxt);
            if constexpr (SP2) {
            PG8_LDB(B0, 0, 0); PG8_LDB(B1, 0, 1); PG8_SCHED; PG8_LDA(At, 0, 0); PG8_STAGE(PG8_SA(1, 1), a1 + hstep, voffA);
            PG8_WAIT_V(8); PG8_WAIT_L(0); PG8_BAR; PG8_MMA(0, 0, At, B0); PG8_MMA(0, 1, At, B1); PG8_BAR; PG8_SCHED;
            PG8_LDA(At, 0, 1); PG8_STAGE(PG8_SB(0, 0), b2, voffB); PG8_STAGE(PG8_SB(0, 1), b2 + hstep, voffB); PG8_STAGE(PG8_SA(0, 0), a2, voffA);
            PG8_WAIT_V(8); PG8_WAIT_L(0); PG8_BAR; PG8_MMA(1, 0, At, B0); PG8_MMA(1, 1, At, B1); PG8_BAR; PG8_SCHED;
            PG8_LDB(B0, 1, 0); PG8_LDB(B1, 1, 1); PG8_SCHED; PG8_LDA(At, 1, 0); PG8_STAGE(PG8_SA(0, 1), a2 + hstep, voffA);
            PG8_WAIT_V(8); PG8_WAIT_L(0); PG8_BAR; PG8_MMA(0, 0, At, B0); PG8_MMA(0, 1, At, B1); PG8_BAR; PG8_SCHED;
            PG8_LDA(At, 1, 1); PG8_STAGE(PG8_SB(1, 0), b3, voffB); PG8_STAGE(PG8_SB(1, 1), b3 + hstep, voffB); PG8_STAGE(PG8_SA(1, 0), a3, voffA);
            PG8_WAIT_V(8); PG8_WAIT_L(0); PG8_BAR; PG8_MMA(1, 0, At, B0); PG8_MMA(1, 1, At, B1); PG8_BAR; PG8_SCHED;
            } else {
            PG8_LDB(B0, 0, 0); PG8_SCHED; PG8_LDA(At, 0, 0); PG8_STAGE(PG8_SA(1, 1), a1 + hstep, voffA);
            PG8_WAIT_L(8); PG8_BAR; PG8_WAIT_L(0); PG8_MMA(0, 0, At, B0); PG8_BAR; PG8_SCHED;
            PG8_LDB(B1, 0, 1); PG8_STAGE(PG8_SB(0, 0), b2, voffB);
            PG8_BAR; PG8_WAIT_L(0); PG8_MMA(0, 1, At, B1); PG8_BAR;
            PG8_LDA(At, 0, 1); PG8_STAGE(PG8_SA(0, 0), a2, voffA);
            PG8_BAR; PG8_WAIT_L(0); PG8_MMA(1, 0, At, B0); PG8_BAR; PG8_SCHED;
            PG8_STAGE(PG8_SB(0, 1), b2 + hstep, voffB);
            PG8_WAIT_V(6); PG8_BAR; PG8_MMA(1, 1, At, B1); PG8_BAR;
            PG8_LDB(B0, 1, 0); PG8_SCHED; PG8_LDA(At, 1, 0); PG8_STAGE(PG8_SA(0, 1), a2 + hstep, voffA);
            PG8_WAIT_L(8); PG8_BAR; PG8_WAIT_L(0); PG8_MMA(0, 0, At, B0); PG8_BAR; PG8_SCHED;
            PG8_LDB(B1, 1, 1); PG8_STAGE(PG8_SB(1, 0), b3, voffB);
            PG8_BAR; PG8_WAIT_L(0); PG8_MMA(0, 1, At, B1); PG8_BAR;
            PG8_LDA(At, 1, 1); PG8_STAGE(PG8_SA(1, 0), a3, voffA);
            PG8_BAR; PG8_WAIT_L(0); PG8_MMA(1, 0, At, B0); PG8_BAR; PG8_SCHED;
            PG8_STAGE(PG8_SB(1, 1), b3 + hstep, voffB);
            PG8_WAIT_V(6); PG8_BAR; PG8_MMA(1, 1, At, B1); PG8_BAR;
            }
        }
        if constexpr (ALIGN_EPI) { if (wr == 0) PG8_BAR; }
        if constexpr (!Epi::AFTER_DRAIN) { E(acc, cur, wr, wc, fr, fq); S.done(cur); }
        if (!has_next) break;
#pragma unroll
        for (int a = 0; a < 2; ++a)
#pragma unroll
            for (int b = 0; b < 2; ++b)
#pragma unroll
                for (int m = 0; m < 4; ++m)
#pragma unroll
                    for (int n = 0; n < 2; ++n) acc[a][b][m][n] = (f32x4){0.f, 0.f, 0.f, 0.f};
        cur = nxt; cA = nA; cB = nB; ++ui;
        if constexpr (ALIGN_EPI) { if (wr == 1) PG8_BAR; }
    }
    PG8_WAIT_V(0);
    if constexpr (!ALIGN_EPI) { if (wr == 0) PG8_BAR; }
    PG8_BAR;
    if constexpr (Epi::AFTER_DRAIN) { E.fused(acc, cur, wr, wc, fr, fq, lds, wid, lane); S.done(cur); }
#undef PG8_SA
#undef PG8_SB
#undef PG8_STAGE
#undef PG8_LDA
#undef PG8_LDB
#undef PG8_MMA
#undef PG8_WAIT_V
#undef PG8_WAIT_L
#undef PG8_BAR
#undef PG8_SCHED
}
}

constexpr int NWAVES = 8;
#ifndef MK_N_LAUNCHES
#define MK_N_LAUNCHES 1
#endif
constexpr int N_PHASES = 14;
constexpr int DM = 2048, TSEQ = 2048, NBATCH = 4, MP = 8192, NSAMP = 128, MV = 8320, MPAD = 8448, FF = 5504, NQKV = 1536, NRW = 3360, NRWP = 3584, NIN = 5120, KL = 384, NL = 3072;
using pg8::sigmoid_f;
constexpr float QSCALE = 0.125f * 1.4426950408889634f, LOG2E = 1.4426950408889634f;
constexpr size_t O_YP = 0, O_YS = 16777216, O_PSHIFT = 17039360, O_PWKV = 17052800, O_PKWIN = 17314944, O_PVWIN = 17446016, O_SSHIFT = 17577088, O_SWKV = 18007168, O_SKWIN = 26395776, O_SVWIN = 30590080, O_END = 34784384;
constexpr size_t MiB = 1u << 20;
constexpr size_t WS_CTL = 0, CTL_ZERO_BYTES = 1 * MiB;
constexpr size_t WS_W1T = 1 * MiB, WS_W2T = 44 * MiB, WS_WINT = 66 * MiB, WS_WOUTT = 86 * MiB, WS_WLT = 94 * MiB, WS_XB = 97 * MiB, WS_H = 130 * MiB, WS_PRW = 219 * MiB, WS_QKV = 335 * MiB, WS_OMIX = 360 * MiB, WS_END = 393 * MiB;
constexpr size_t WS_LWW = WS_H, WS_LWA = WS_H + (size_t)MPAD * 1024 * 4, WS_LWG = WS_H + (size_t)MPAD * 1024 * 8, WS_ALORA = WS_H + (size_t)MPAD * 1024 * 10;
constexpr size_t WS_ORAW = WS_XB;
static_assert(WS_ALORA + (size_t)MPAD * KL * 2 <= WS_H + (size_t)MPAD * FF * 2 && WS_H + (size_t)MPAD * FF * 2 <= WS_PRW && WS_PRW + (size_t)MPAD * NRWP * 4 <= WS_QKV && WS_QKV + (size_t)MPAD * NQKV * 2 <= WS_OMIX && WS_OMIX + (size_t)MPAD * DM * 2 <= WS_END, "ws map");
static_assert(WS_W1T + (size_t)2 * FF * DM * 2 <= WS_W2T && WS_W2T + (size_t)FF * DM * 2 <= WS_WINT && WS_WINT + (size_t)NIN * DM * 2 <= WS_WOUTT && WS_WOUTT + (size_t)DM * DM * 2 <= WS_WLT && WS_WLT + (size_t)NL * KL * 2 <= WS_XB && WS_XB + (size_t)MPAD * DM * 2 <= WS_H, "ws map 2");
constexpr int CW_BAR = 4096, CW_SS = 16384, SS_STRIDE = 16384, CW_ZROW = 131072;
constexpr int RING_BYTES = 131072, LDSCTL_OFF = RING_BYTES, MISC_OFF = LDSCTL_OFF + 320, LDS_BYTES = 147456;

#define GAS __attribute__((address_space(1)))
#define LAS __attribute__((address_space(3)))
typedef unsigned short bf16;
typedef unsigned v4u __attribute__((ext_vector_type(4)));
typedef unsigned v2u __attribute__((ext_vector_type(2)));
typedef float f32x4 __attribute__((ext_vector_type(4)));
typedef short bf16x8 __attribute__((ext_vector_type(8)));
typedef short s16x4 __attribute__((ext_vector_type(4)));
#define LDS_WAIT() asm volatile("s_waitcnt lgkmcnt(0)" ::: "memory")
#define VM_WAIT() asm volatile("s_waitcnt vmcnt(0)" ::: "memory")
__device__ __forceinline__ unsigned f2bf(float f) { unsigned u = __builtin_bit_cast(unsigned, f); return (u + 0x7fffu + ((u >> 16) & 1u)) >> 16; }
__device__ __forceinline__ unsigned pk2(float lo, float hi) { return f2bf(lo) | (f2bf(hi) << 16); }
__device__ __forceinline__ float bf2f(unsigned short b) { return __builtin_bit_cast(float, (unsigned)b << 16); }
__device__ __forceinline__ float bflo(unsigned w) { return __builtin_bit_cast(float, w << 16); }
__device__ __forceinline__ float bfhi(unsigned w) { return __builtin_bit_cast(float, w & 0xffff0000u); }
#define XB_TMO      128
#define XB_XCNT(j)  (256  + 64 * (j))
#define XB_XSUB(j)  (1280 + 64 * (j))
#define XB_XGEN(j)  (2304 + 64 * (j))
#define XB_TOP      3328
#define XB_TOPGEN   3392
#define XCD_BAR_WORDS 3456
#define XB_SPIN_CAP (1u << 18)

__device__ __forceinline__ unsigned xb_ld(unsigned* p)              { return __hip_atomic_load(p, __ATOMIC_RELAXED, __HIP_MEMORY_SCOPE_AGENT); }
__device__ __forceinline__ unsigned xb_add(unsigned* p, unsigned v) { return __hip_atomic_fetch_add(p, v, __ATOMIC_RELAXED, __HIP_MEMORY_SCOPE_AGENT); }
__device__ __forceinline__ unsigned xb_xcc_id() { return (unsigned)__builtin_amdgcn_s_getreg((3 << 11) | 20) & 0xFu; }
#define XB_SPIN(cond, bar) do { unsigned _sp = 0; while (cond) { __builtin_amdgcn_s_sleep(1); \
    if ((++_sp & 255u) == 0u) { if (xb_ld(&(bar)[XB_TMO])) break; if (_sp > XB_SPIN_CAP) { atomicAdd(&(bar)[XB_TMO], 1u); break; } } } } while (0)

struct XcdBarrier {
    unsigned* bar; unsigned x;
    volatile LAS unsigned* st;
};

__device__ __forceinline__ XcdBarrier xcd_barrier_post(unsigned* bar, volatile LAS unsigned* st) {
    XcdBarrier b; b.bar = bar; b.x = xb_xcc_id(); b.st = st;
    if (threadIdx.x == 0) (void)xb_add(&bar[XB_XCNT(b.x)], 1u);
    return b;
}
__device__ __forceinline__ void xcd_barrier_complete(unsigned* bar, unsigned x, unsigned& nloc, unsigned& nx) {
    const unsigned G = gridDim.x * gridDim.y * gridDim.z;
    unsigned sum, cnt, mine, sp = 0u;
    for (;;) {
        sum = 0u; cnt = 0u; mine = 0u;
#pragma unroll
        for (unsigned j = 0; j < 16; ++j) { const unsigned c = xb_ld(&bar[XB_XCNT(j)]); sum += c; cnt += (c > 0u) ? 1u : 0u; mine = (j == x) ? c : mine; }
        if (sum == G) break;
        __builtin_amdgcn_s_sleep(1);
        if ((++sp & 255u) == 0u) { if (xb_ld(&bar[XB_TMO])) break; if (sp > XB_SPIN_CAP) { atomicAdd(&bar[XB_TMO], 1u); break; } }
    }
    nloc = mine > 0u ? mine : 1u; nx = cnt > 0u ? cnt : 1u;
}

__device__ __forceinline__ void xcd_barrier(const XcdBarrier& b) {
    asm volatile("s_waitcnt vmcnt(0)" ::: "memory");
    __syncthreads();
    if (threadIdx.x == 0) {
        unsigned* bar = b.bar;
        __builtin_amdgcn_s_waitcnt(0);
        unsigned nloc = b.st[0], nx = b.st[1];
        if (nloc == 0u) { xcd_barrier_complete(bar, b.x, nloc, nx); b.st[0] = nloc; b.st[1] = nx; }
        const unsigned old = xb_add(&bar[XB_XSUB(b.x)], 1u);
        const unsigned gen = old / nloc;
        if (old + 1u == (gen + 1u) * nloc) {
            __builtin_amdgcn_fence(__ATOMIC_RELEASE, "agent");
            asm volatile("s_waitcnt vmcnt(0)" ::: "memory");
            const unsigned og = xb_add(&bar[XB_TOP], 1u);
            const unsigned tg = og / nx;
            if (og + 1u == (tg + 1u) * nx) xb_add(&bar[XB_TOPGEN], 1u);
            else XB_SPIN(xb_ld(&bar[XB_TOPGEN]) == tg, bar);
            __builtin_amdgcn_fence(__ATOMIC_ACQUIRE, "agent");
            xb_add(&bar[XB_XGEN(b.x)], 1u);
            asm volatile("s_waitcnt vmcnt(0)" ::: "memory");
        } else {
            XB_SPIN(xb_ld(&bar[XB_XGEN(b.x)]) == gen, bar);
            __builtin_amdgcn_fence(__ATOMIC_ACQUIRE, "agent");
            asm volatile("s_waitcnt vmcnt(0)" ::: "memory");
        }
    }
    __syncthreads();
}
struct Args { const float* in[30]; float* out; unsigned char* ws; int ph_lo, ph_hi; };
enum { I_XP = 0, I_XS, I_SSHIFT, I_SWKV, I_CK, I_CV, I_N1, I_W1G, I_W1U, I_W1D, I_NMIX, I_WIN, I_MU, I_DUP, I_DBASE, I_IUP, I_IBASE, I_GUP, I_KK, I_KA, I_RK, I_LNG, I_LNB, I_SINK, I_WOUT, I_N2, I_W2G, I_W2U, I_W2D, I_NF };

struct Ctx { LAS unsigned char* lds; int tid, lane, wave, gw, ngw; };

template <int CTRL> __device__ __forceinline__ float dpp_f(float x) { return __builtin_bit_cast(float, __builtin_amdgcn_mov_dpp(__builtin_bit_cast(int, x), CTRL, 0xf, 0xf, true)); }
__device__ __forceinline__ float red8(float x) { x += dpp_f<0xB1>(x); x += dpp_f<0x4E>(x); x += dpp_f<0x141>(x); return x; }
__device__ __forceinline__ float red16(float x) { x = red8(x); x += dpp_f<0x140>(x); return x; }
__device__ __forceinline__ float wave_sum(float v) {
#pragma unroll
    for (int o = 1; o < 64; o <<= 1) v += __shfl_xor(v, o);
    return v;
}
__device__ __forceinline__ float wave_max(float v) {
#pragma unroll
    for (int o = 1; o < 64; o <<= 1) v = fmaxf(v, __shfl_xor(v, o));
    return v;
}
__device__ __forceinline__ float dot4(f32x4 a, f32x4 b) { return (a[0] * b[0] + a[1] * b[1]) + (a[2] * b[2] + a[3] * b[3]); }

template <int MODE> __device__ __forceinline__ void tr_item(const float* W, int K, int N, const float* gain, bf16* WT, LAS float* scr, int item, int lane) {
    const int nblk = (N + 63) / 64, kb = item / nblk, nb = item % nblk, k0 = 64 * kb, n0 = 64 * nb;
    const int kl = lane >> 4, nq = lane & 15; const bool ld_ok = n0 + 4 * nq < N;
#pragma unroll
    for (int hlf = 0; hlf < 2; ++hlf) { f32x4 v[8];
#pragma unroll
        for (int i = 0; i < 8; ++i) { const int k = 32 * hlf + 4 * i + kl; v[i] = (f32x4){0.f, 0.f, 0.f, 0.f}; if (ld_ok) v[i] = *(const f32x4*)(W + (size_t)(k0 + k) * N + n0 + 4 * nq); }
#pragma unroll
        for (int i = 0; i < 8; ++i) { const int k = 32 * hlf + 4 * i + kl; f32x4 x = v[i]; if (gain) x = x * gain[k0 + k];
            *(LAS f32x4*)(scr + k * 64 + 4 * (nq ^ ((k >> 3) & 7))) = x; } }
    LDS_WAIT(); asm volatile("" ::: "memory");
    const int c = lane & 7;
#pragma unroll
    for (int j = 0; j < 8; ++j) { const int n = (lane >> 3) + 8 * j; const LAS float* s = scr + (8 * c) * 64 + 4 * ((n >> 2) ^ c) + (n & 3);
        v4u o; o.x = pk2(s[0 * 64], s[1 * 64]); o.y = pk2(s[2 * 64], s[3 * 64]); o.z = pk2(s[4 * 64], s[5 * 64]); o.w = pk2(s[6 * 64], s[7 * 64]);
        const int ng = n0 + n; const int row = MODE == 0 ? ng : (256 * (ng >> 7) + (ng & 127) + (MODE == 2 ? 128 : 0));
        if (ng < N) *(v4u*)(WT + (size_t)row * K + k0 + 8 * c) = o; }
    LDS_WAIT(); asm volatile("" ::: "memory");
}
__device__ __forceinline__ void convert_ffn(const Ctx& C, const float* Wg, const float* Wu, const float* Wd, const float* gain, bf16* W1T, bf16* W2T) {
    LAS float* scr = (LAS float*)(C.lds + C.wave * 16384);
    constexpr int I_G = (DM / 64) * (FF / 64), I_D = (FF / 64) * (DM / 64);
    for (int it = C.gw; it < 2 * I_G + I_D; it += C.ngw) {
        int r = it;
        if (r < I_G) { tr_item<1>(Wg, DM, FF, gain, W1T, scr, r, C.lane); continue; } r -= I_G;
        if (r < I_G) { tr_item<2>(Wu, DM, FF, gain, W1T, scr, r, C.lane); continue; } r -= I_G;
        tr_item<0>(Wd, FF, DM, nullptr, W2T, scr, r, C.lane);
    }
}

__device__ __forceinline__ void phase_prologue(const Ctx& C, const Args& a) {
    unsigned char* ws = a.ws;
    convert_ffn(C, a.in[I_W1G], a.in[I_W1U], a.in[I_W1D], a.in[I_N1], (bf16*)(ws + WS_W1T), (bf16*)(ws + WS_W2T));
    {
        LAS float* scr = (LAS float*)(C.lds + C.wave * 16384);
        constexpr int I_IN = (DM / 64) * ((4896 + 63) / 64), I_OUT = (DM / 64) * (DM / 64);
        for (int it = C.gw; it < I_IN + I_OUT; it += C.ngw) {
            if (it < I_IN) tr_item<0>(a.in[I_WIN], DM, 4896, a.in[I_NMIX], (bf16*)(ws + WS_WINT), scr, it, C.lane);
            else tr_item<0>(a.in[I_WOUT], DM, DM, nullptr, (bf16*)(ws + WS_WOUTT), scr, it - I_IN, C.lane);
        }
    }
    {
        v4u* z = (v4u*)((bf16*)(ws + WS_WINT) + (size_t)4896 * DM);
        for (int i = C.gw * 64 + C.lane; i < 224 * DM / 8; i += C.ngw * 64) z[i] = (v4u){0u, 0u, 0u, 0u};
    }
    {
        unsigned* WL = (unsigned*)(ws + WS_WLT);
        for (int e = C.gw * 64 + C.lane; e < (KL / 2) * NL; e += C.ngw * 64) { const int kp = e / NL, n = e % NL; float v[2];
#pragma unroll
            for (int i = 0; i < 2; ++i) { const int k = 2 * kp + i; v[i] = 0.f;
                if (n < 1024) { if (k < 64) v[i] = a.in[I_DUP][k * 1024 + n]; }
                else if (n < 2048) { if (k >= 64 && k < 128) v[i] = a.in[I_IUP][(k - 64) * 1024 + (n - 1024)]; }
                else { if (k >= 128 && k < 288) v[i] = a.in[I_GUP][(k - 128) * 1024 + (n - 2048)]; } }
            WL[((size_t)n * KL + 2 * kp) / 2] = pk2(v[0], v[1]); }
    }
    {
        bf16* XB = (bf16*)(ws + WS_XB); float* ss1 = (float*)(ws + WS_CTL) + CW_SS;
        for (int m = C.gw; m < MPAD; m += C.ngw) {
            const float* xr = m < MP ? a.in[I_XP] + (size_t)m * DM : a.in[I_XS] + (size_t)(m - MP) * DM;
            float s = 0.f;
#pragma unroll
            for (int j = 0; j < 8; ++j) { f32x4 v = (f32x4){0.f, 0.f, 0.f, 0.f}; if (m < MV) v = *((const f32x4*)xr + C.lane + 64 * j);
                s += dot4(v, v); v2u o; o.x = pk2(v[0], v[1]); o.y = pk2(v[2], v[3]); *((v2u*)(XB + (size_t)m * DM) + C.lane + 64 * j) = o; }
            s = wave_sum(s); if (C.lane == 0) ss1[m] = s;
        }
    }
}

struct Ops { f32x4 na, w, b, kp, r, v; };
__device__ __forceinline__ f32x4 sig4(f32x4 x) { return (f32x4){sigmoid_f(x[0]), sigmoid_f(x[1]), sigmoid_f(x[2]), sigmoid_f(x[3])}; }
__device__ __forceinline__ f32x4 decay4(f32x4 x) { const f32x4 s = sig4(x); return (f32x4){__builtin_amdgcn_exp2f(-0.8750387749f * s[0]), __builtin_amdgcn_exp2f(-0.8750387749f * s[1]), __builtin_amdgcn_exp2f(-0.8750387749f * s[2]), __builtin_amdgcn_exp2f(-0.8750387749f * s[3])}; }
struct RwConst { const float* mu; const float* k_k; const float* k_a; };
template <bool WITH_W> __device__ __forceinline__ void prep_ops(Ops& o, const float* prow, const float* pprev, const float* wrow, const float* arow, const RwConst& rc, int hk) {
    const f32x4 pr = *(const f32x4*)(prow + hk), pk = *(const f32x4*)(prow + 1024 + hk), pv = *(const f32x4*)(prow + 2048 + hk);
    const f32x4 qr = *(const f32x4*)(pprev + hk), qk = *(const f32x4*)(pprev + 1024 + hk), qv = *(const f32x4*)(pprev + 2048 + hk);
    const f32x4 mr = *(const f32x4*)(rc.mu + hk), mk = *(const f32x4*)(rc.mu + 1024 + hk), mv = *(const f32x4*)(rc.mu + 2048 + hk);
    const f32x4 a4 = sig4(*(const f32x4*)(arow + hk)), kk4 = *(const f32x4*)(rc.k_k + hk), ka4 = *(const f32x4*)(rc.k_a + hk);
    const f32x4 ur = pr + mr * (qr - pr), uk = pk + mk * (qk - pk), uv = pv + mv * (qv - pv);
    const f32x4 kk = uk * kk4;
    const float n2 = red16(dot4(kk, kk));
    const float inv = 1.0f / fmaxf(sqrtf(n2), 1e-12f);
    const f32x4 kkn = kk * inv;
    o.na = -kkn; o.b = kkn * a4; o.kp = uk * (1.0f + (a4 - 1.0f) * ka4); o.r = ur; o.v = uv;
    if (WITH_W) o.w = decay4(*(const f32x4*)(wrow + hk)); else o.w = (f32x4){0.f, 0.f, 0.f, 0.f};
}

typedef short v4i16_t __attribute__((ext_vector_type(4)));
constexpr int AT_STRIDE = 160, AT_ROWS = 272, AT_KOFF = 0, AT_VOFF = AT_ROWS * AT_STRIDE, AT_END = 2 * AT_ROWS * AT_STRIDE;
__device__ __forceinline__ void attn_prompt_unit(const Ctx& C, const Args& a, int unit) {
    const bf16* QKV = (const bf16*)(a.ws + WS_QKV); bf16* OMIX = (bf16*)(a.ws + WS_OMIX);
    const int b = unit >> 6, nb = (unit >> 2) & 15, c = unit & 3;
    const int m0 = b * TSEQ + nb * 128;
    LAS unsigned char* Kt = C.lds + AT_KOFF; LAS unsigned char* Vt = C.lds + AT_VOFF;
    __syncthreads();
    for (int i = C.tid; i < 2 * AT_ROWS * 8; i += 512) { const int which = i / (AT_ROWS * 8), r = (i % (AT_ROWS * 8)) >> 3, ch = i & 7;
        v4u v = (v4u){0u, 0u, 0u, 0u};
        if (r < 256 && (nb > 0 || r >= 128)) v = *(const v4u*)(QKV + (size_t)(m0 - 128 + r) * NQKV + 1024 + which * 256 + c * 64 + ch * 8);
        *(LAS v4u*)((which ? Vt : Kt) + r * AT_STRIDE + ch * 16) = v; }
    __syncthreads();
    const int w = C.wave, fr = C.lane & 15, fq = C.lane >> 4;
#pragma unroll 1
    for (int hq = 0; hq < 4; ++hq) { const int h = 4 * c + hq;
        const float slope2 = __builtin_amdgcn_exp2f(-0.5f * (float)(h + 1)) * LOG2E, sink2 = a.in[I_SINK][h] * LOG2E;
        const bf16* qp = QKV + (size_t)(m0 + 16 * w + fr) * NQKV + h * 64 + 8 * fq;
        const bf16x8 q0 = *(const bf16x8*)qp, q1 = *(const bf16x8*)(qp + 32);
        f32x4 s[10];
#pragma unroll
        for (int kt = 0; kt < 10; ++kt) { const LAS unsigned char* kp = Kt + (16 * (w + kt) + fr) * AT_STRIDE + 16 * fq;
            const bf16x8 k0 = *(const LAS bf16x8*)kp, k1 = *(const LAS bf16x8*)(kp + 64);
            f32x4 acc = (f32x4){0.f, 0.f, 0.f, 0.f};
            acc = __builtin_amdgcn_mfma_f32_16x16x32_bf16(k0, q0, acc, 0, 0, 0); acc = __builtin_amdgcn_mfma_f32_16x16x32_bf16(k1, q1, acc, 0, 0, 0);
            s[kt] = acc; }
        const int qi = 16 * w + fr; float mx = sink2;
#pragma unroll
        for (int kt = 0; kt < 10; ++kt)
#pragma unroll
            for (int r = 0; r < 4; ++r) { const int kj = 16 * (w + kt) + 4 * fq + r, dist = 128 + qi - kj; const bool ok = dist >= 0 && dist < 128 && (nb > 0 || kj >= 128);
                const float v = ok ? s[kt][r] - slope2 * (float)dist : -1e30f; s[kt][r] = v; mx = fmaxf(mx, v); }
        mx = fmaxf(mx, __shfl_xor(mx, 16)); mx = fmaxf(mx, __shfl_xor(mx, 32));
        float sum = 0.f;
#pragma unroll
        for (int kt = 0; kt < 10; ++kt)
#pragma unroll
            for (int r = 0; r < 4; ++r) { const float p = __builtin_amdgcn_exp2f(s[kt][r] - mx); s[kt][r] = p; sum += p; }
        sum += __shfl_xor(sum, 16); sum += __shfl_xor(sum, 32);
        const float inv = 1.0f / (sum + __builtin_amdgcn_exp2f(sink2 - mx));
        f32x4 o[4];
#pragma unroll
        for (int dt = 0; dt < 4; ++dt) o[dt] = (f32x4){0.f, 0.f, 0.f, 0.f};
#pragma unroll
        for (int st = 0; st < 5; ++st) {
            union { bf16x8 v; unsigned u[4]; } pb;
            pb.u[0] = pk2(s[2 * st][0], s[2 * st][1]); pb.u[1] = pk2(s[2 * st][2], s[2 * st][3]); pb.u[2] = pk2(s[2 * st + 1][0], s[2 * st + 1][1]); pb.u[3] = pk2(s[2 * st + 1][2], s[2 * st + 1][3]);
#pragma unroll
            for (int dt = 0; dt < 4; ++dt) {
                const LAS unsigned char* vp = Vt + (16 * (w + 2 * st) + 4 * fq + (fr >> 2)) * AT_STRIDE + (16 * dt + 4 * (fr & 3)) * 2;
                const v4i16_t t0 = __builtin_amdgcn_ds_read_tr16_b64_v4i16((LAS v4i16_t*)vp), t1 = __builtin_amdgcn_ds_read_tr16_b64_v4i16((LAS v4i16_t*)(vp + 16 * AT_STRIDE));
                bf16x8 va; va[0] = t0[0]; va[1] = t0[1]; va[2] = t0[2]; va[3] = t0[3]; va[4] = t1[0]; va[5] = t1[1]; va[6] = t1[2]; va[7] = t1[3];
                o[dt] = __builtin_amdgcn_mfma_f32_16x16x32_bf16(va, pb.v, o[dt], 0, 0, 0); } }
        bf16* op = OMIX + (size_t)(m0 + 16 * w + fr) * DM + 1024 + h * 64 + 4 * fq;
#pragma unroll
        for (int dt = 0; dt < 4; ++dt) { v2u ov; ov.x = pk2(o[dt][0] * inv, o[dt][1] * inv); ov.y = pk2(o[dt][2] * inv, o[dt][3] * inv); *(v2u*)(op + 16 * dt) = ov; }
    }
}
__device__ __forceinline__ void attn_sample_item(const Ctx& C, const Args& a, int item, LAS float* scr  ) {
    const bf16* QKV = (const bf16*)(a.ws + WS_QKV); bf16* OMIX = (bf16*)(a.ws + WS_OMIX);
    const int b = item >> 2, c = item & 3, lane = C.lane; const int mrow = MP + b;
    LAS float* qs = scr; LAS float* ps = scr + 256;
#pragma unroll
    for (int hq = 0; hq < 4; ++hq) qs[hq * 64 + lane] = bf2f(QKV[(size_t)mrow * NQKV + (4 * c + hq) * 64 + lane]);
    LDS_WAIT(); asm volatile("" ::: "memory");
    const float* ck = a.in[I_CK] + ((size_t)b * 128 * 4 + c) * 64; const float* cv = a.in[I_CV] + ((size_t)b * 128 * 4 + c) * 64;
    float* kw = a.out + O_SKWIN + ((size_t)b * 128 * 4 + c) * 64; float* vw = a.out + O_SVWIN + ((size_t)b * 128 * 4 + c) * 64;
#pragma unroll 1
    for (int jj = 0; jj < 2; ++jj) { const int j = lane + 64 * jj;
        float d0 = 0.f, d1 = 0.f, d2 = 0.f, d3 = 0.f;
#pragma unroll 1
        for (int hf = 0; hf < 2; ++hf) { f32x4 kv[8]; const float* kr = ck + (size_t)j * 256 + 32 * hf; float* kwr = kw + (size_t)(j - 1) * 256 + 32 * hf; const LAS float* qh = qs + 32 * hf;
#pragma unroll
            for (int d4 = 0; d4 < 8; ++d4) kv[d4] = *(const f32x4*)(kr + 4 * d4);
#pragma unroll
            for (int d4 = 0; d4 < 8; ++d4) { if (j >= 1) *(f32x4*)(kwr + 4 * d4) = kv[d4];
                d0 += dot4(kv[d4], *(const LAS f32x4*)(qh + 0 * 64 + 4 * d4)); d1 += dot4(kv[d4], *(const LAS f32x4*)(qh + 1 * 64 + 4 * d4));
                d2 += dot4(kv[d4], *(const LAS f32x4*)(qh + 2 * 64 + 4 * d4)); d3 += dot4(kv[d4], *(const LAS f32x4*)(qh + 3 * 64 + 4 * d4)); } }
        ps[0 * 132 + j] = d0; ps[1 * 132 + j] = d1; ps[2 * 132 + j] = d2; ps[3 * 132 + j] = d3; }
    { const float kn = bf2f(QKV[(size_t)mrow * NQKV + 1024 + c * 64 + lane]);
      const float e0 = wave_sum(kn * qs[lane]), e1 = wave_sum(kn * qs[64 + lane]), e2 = wave_sum(kn * qs[128 + lane]), e3 = wave_sum(kn * qs[192 + lane]);
      if (lane == 0) { ps[0 * 132 + 128] = e0; ps[1 * 132 + 128] = e1; ps[2 * 132 + 128] = e2; ps[3 * 132 + 128] = e3; } }
    LDS_WAIT(); asm volatile("" ::: "memory");
#pragma unroll 1
    for (int hq = 0; hq < 4; ++hq) { const int h = 4 * c + hq;
        const float slope2 = __builtin_amdgcn_exp2f(-0.5f * (float)(h + 1)) * LOG2E, sink2 = a.in[I_SINK][h] * LOG2E;
        const float v0 = lane >= 1 ? ps[hq * 132 + lane] - slope2 * (float)(128 - lane) : -1e30f;
        const float v1 = ps[hq * 132 + 64 + lane] - slope2 * (float)(64 - lane);
        const float v2 = ps[hq * 132 + 128];
        const float mx = wave_max(fmaxf(fmaxf(v0, v1), fmaxf(v2, sink2)));
        const float p0 = __builtin_amdgcn_exp2f(v0 - mx), p1 = __builtin_amdgcn_exp2f(v1 - mx), p2 = __builtin_amdgcn_exp2f(v2 - mx);
        const float tot = wave_sum(p0 + p1) + p2 + __builtin_amdgcn_exp2f(sink2 - mx); const float inv = 1.0f / tot;
        LDS_WAIT(); asm volatile("" ::: "memory");
        ps[hq * 132 + lane] = p0 * inv; ps[hq * 132 + 64 + lane] = p1 * inv; if (lane == 0) ps[hq * 132 + 128] = p2 * inv; }
    LDS_WAIT(); asm volatile("" ::: "memory");
    float o0 = 0.f, o1 = 0.f, o2 = 0.f, o3 = 0.f;
#pragma unroll 1
    for (int jb = 0; jb < 128; jb += 16) { float vv[16];
#pragma unroll
        for (int i = 0; i < 16; ++i) vv[i] = cv[(size_t)(jb + i) * 256 + lane];
#pragma unroll
        for (int i = 0; i < 16; ++i) { const int j = jb + i; if (j >= 1) vw[(size_t)(j - 1) * 256 + lane] = vv[i];
            o0 += ps[0 * 132 + j] * vv[i]; o1 += ps[1 * 132 + j] * vv[i]; o2 += ps[2 * 132 + j] * vv[i]; o3 += ps[3 * 132 + j] * vv[i]; } }
    { const float vv = bf2f(QKV[(size_t)mrow * NQKV + 1280 + c * 64 + lane]);
      o0 += ps[0 * 132 + 128] * vv; o1 += ps[1 * 132 + 128] * vv; o2 += ps[2 * 132 + 128] * vv; o3 += ps[3 * 132 + 128] * vv; }
    bf16* op = OMIX + (size_t)mrow * DM + 1024 + (4 * c) * 64 + lane;
    op[0] = (bf16)f2bf(o0); op[64] = (bf16)f2bf(o1); op[128] = (bf16)f2bf(o2); op[192] = (bf16)f2bf(o3);
    LDS_WAIT(); asm volatile("" ::: "memory");
}
__device__ __forceinline__ void phase_mixprep(const Ctx& C, const Args& a) {
    unsigned char* ws = a.ws;
    const float* PRW = (const float*)(ws + WS_PRW); const float* ZROW = (const float*)(ws + WS_CTL) + CW_ZROW;
#ifndef MIX_DUP
#define MIX_DUP 0
#endif
    for (int rep = 0; rep < ((MIX_DUP & 1) ? 2 : 1); ++rep)
    for (int unit = blockIdx.x; unit < 256; unit += gridDim.x) attn_prompt_unit(C, a, unit);
    __syncthreads();
    for (int rep = 0; rep < ((MIX_DUP & 2) ? 2 : 1); ++rep)
    for (int it = C.gw; it < NSAMP * 4; it += C.ngw) attn_sample_item(C, a, it, (LAS float*)(C.lds + C.wave * 16384));
    { bf16* AL = (bf16*)(ws + WS_ALORA); const float* mu = a.in[I_MU] + 3072;
      for (int m = C.gw; m < MPAD; m += C.ngw) {
        const float* prow = PRW + (size_t)m * NRWP + 3072;
        const float* pprev = m < MP ? ((m & 2047) ? prow - NRWP : ZROW) : (m < MV ? a.in[I_SSHIFT] + (size_t)(m - MP) * NRW + 3072 : ZROW);
#pragma unroll
        for (int jj = 0; jj < 6; ++jj) { const int j = C.lane + 64 * jj; float v = 0.f;
            if (j < 288 && m < MV) { const float p = prow[j]; const float u = p + mu[j] * (pprev[j] - p);
                v = j < 64 ? (2.0f * sigmoid_f(2.0f * u) - 1.0f) : (j < 128 ? u : sigmoid_f(u)); }
            AL[(size_t)m * KL + j] = (bf16)f2bf(v); } } }
    for (int r = C.gw; r < NBATCH + NSAMP; r += C.ngw) {
        const float* src = PRW + (size_t)(r < NBATCH ? r * TSEQ + TSEQ - 1 : MP + (r - NBATCH)) * NRWP;
        float* dst = r < NBATCH ? a.out + O_PSHIFT + (size_t)r * NRW : a.out + O_SSHIFT + (size_t)(r - NBATCH) * NRW;
        for (int j = C.lane; j < NRW / 4; j += 64) *((f32x4*)dst + j) = *((const f32x4*)src + j); }
    for (int rep = 0; rep < ((MIX_DUP & 4) ? 2 : 1); ++rep)
    convert_ffn(C, a.in[I_W2G], a.in[I_W2U], a.in[I_W2D], a.in[I_N2], (bf16*)(ws + WS_W1T), (bf16*)(ws + WS_W2T));
}

constexpr int SC_CH = 16, SC_NCH = TSEQ / SC_CH, SC_OPB = SC_CH * 6 * 64, SC_OPART = SC_CH * 256;
typedef float f32x2 __attribute__((ext_vector_type(2)));
struct StRaw { f32x4 pr, pk, pv, qr, qk, qv, w, a; };
__device__ __forceinline__ void phase_scan(const Ctx& C, const Args& a) {
    unsigned char* ws = a.ws;
    const float* PRW = (const float*)(ws + WS_PRW); const float* ZROW = (const float*)(ws + WS_CTL) + CW_ZROW;
    const float* LWW = (const float*)(ws + WS_LWW); const float* LWA = (const float*)(ws + WS_LWA); float* ORAW = (float*)(ws + WS_ORAW);
    const RwConst rc{a.in[I_MU], a.in[I_KK], a.in[I_KA]};
    LAS float* opb = (LAS float*)C.lds; LAS float* opart = (LAS float*)(C.lds + 2 * SC_OPB * 4);
    const int wave = C.wave, lane = C.lane;
    for (int item = blockIdx.x; item < 256; item += gridDim.x) {
        const int chain = item >> 2, qr = item & 3, b = chain >> 4, h = chain & 15;
        const size_t mbase = (size_t)b * TSEQ;
        const int st_id = (C.tid - 256) & 255, st_t = st_id >> 4, st_kg = lane & 15, hk = h * 64 + 4 * st_kg;
        const f32x4 mr = *(const f32x4*)(rc.mu + hk), mk = *(const f32x4*)(rc.mu + 1024 + hk), mv = *(const f32x4*)(rc.mu + 2048 + hk), kk4 = *(const f32x4*)(rc.k_k + hk), ka4 = *(const f32x4*)(rc.k_a + hk);
        StRaw raw;
        auto st_load = [&](int c) { const int t = c * SC_CH + st_t; const float* prow = PRW + (mbase + t) * NRWP; const float* pp = t ? prow - NRWP : ZROW;
            raw.pr = *(const f32x4*)(prow + hk); raw.pk = *(const f32x4*)(prow + 1024 + hk); raw.pv = *(const f32x4*)(prow + 2048 + hk);
            raw.qr = *(const f32x4*)(pp + hk); raw.qk = *(const f32x4*)(pp + 1024 + hk); raw.qv = *(const f32x4*)(pp + 2048 + hk);
            raw.w = *(const f32x4*)(LWW + (mbase + t) * 1024 + hk); raw.a = *(const f32x4*)(LWA + (mbase + t) * 1024 + hk); };
        auto st_emit = [&](int c) { LAS float* ob = opb + (c & 1) * SC_OPB + st_t * 384 + 4 * st_kg;
            const f32x4 ur = raw.pr + mr * (raw.qr - raw.pr), uk = raw.pk + mk * (raw.qk - raw.pk), uv = raw.pv + mv * (raw.qv - raw.pv);
            const f32x4 kk = uk * kk4; const float n2 = red16(dot4(kk, kk)); const float inv = 1.0f / fmaxf(sqrtf(n2), 1e-12f); const f32x4 kkn = kk * inv;
            const f32x4 aa = sig4(raw.a);
            *(LAS f32x4*)(ob + 0 * 64) = -kkn; *(LAS f32x4*)(ob + 1 * 64) = decay4(raw.w); *(LAS f32x4*)(ob + 2 * 64) = kkn * aa;
            *(LAS f32x4*)(ob + 3 * 64) = uk * (1.0f + (aa - 1.0f) * ka4); *(LAS f32x4*)(ob + 4 * 64) = ur; *(LAS f32x4*)(ob + 5 * 64) = uv; };
        auto st_flush = [&](int c) {
            const LAS float* pp = opart + (c & 1) * SC_OPART + st_id * 4;
#pragma unroll
            for (int i = 0; i < 4; ++i) { const f32x4 p0 = *(const LAS f32x4*)(pp + i * 1024); float s = (p0[0] + p0[1]) + (p0[2] + p0[3]);
                s += dpp_f<0xB1>(s); s += dpp_f<0x4E>(s);
                const int tr = i * 64 + (st_id >> 2);
                if ((st_id & 3) == 0) ORAW[(mbase + c * SC_CH + (tr >> 4)) * 1024 + h * 64 + 16 * qr + (tr & 15)] = s; } };
        const int row_l = lane >> 4, kq = lane & 15, vrow = 16 * qr + 4 * wave + row_l;
        f32x2 S01 = (f32x2){0.f, 0.f}, S23 = (f32x2){0.f, 0.f};
        __syncthreads();
        if (wave < 4) __builtin_amdgcn_s_setprio(3);
        if (wave >= 4) { st_load(0); st_emit(0); st_load(1); }
        __syncthreads();
#pragma unroll 1
        for (int c = 0; c < SC_NCH; ++c) {
            if (wave < 4) {
                const LAS float* ob = opb + (c & 1) * SC_OPB + 4 * kq; const LAS float* vb = opb + (c & 1) * SC_OPB + 320 + vrow;
                LAS float* oo = opart + (c & 1) * SC_OPART + (4 * wave + row_l) * 16 + kq;
                f32x4 na = *(const LAS f32x4*)(ob), w4 = *(const LAS f32x4*)(ob + 64), b4 = *(const LAS f32x4*)(ob + 128), k4 = *(const LAS f32x4*)(ob + 192), r4 = *(const LAS f32x4*)(ob + 256);
                float vv = vb[0];
#pragma unroll
                for (int t = 0; t < SC_CH; ++t) { const LAS float* p = ob + (t + 1) * 384;
                    f32x4 na_n, w4_n, b4_n, k4_n, r4_n; float vv_n;
                    if (t + 1 < SC_CH) { na_n = *(const LAS f32x4*)(p); w4_n = *(const LAS f32x4*)(p + 64); b4_n = *(const LAS f32x4*)(p + 128); k4_n = *(const LAS f32x4*)(p + 192); r4_n = *(const LAS f32x4*)(p + 256); vv_n = vb[(t + 1) * 384]; }
                    f32x2 d = S01 * (f32x2){na[0], na[1]}; d = S23 * (f32x2){na[2], na[3]} + d;
                    const float sa = red16(d[0] + d[1]);
                    const f32x2 vk01 = (f32x2){k4[0], k4[1]} * vv, vk23 = (f32x2){k4[2], k4[3]} * vv;
                    const f32x2 t01 = (f32x2){b4[0], b4[1]} * sa + vk01, t23 = (f32x2){b4[2], b4[3]} * sa + vk23;
                    S01 = S01 * (f32x2){w4[0], w4[1]} + t01; S23 = S23 * (f32x2){w4[2], w4[3]} + t23;
                    f32x2 e = S01 * (f32x2){r4[0], r4[1]}; e = S23 * (f32x2){r4[2], r4[3]} + e;
                    oo[t * 256] = e[0] + e[1];
                    if (t + 1 < SC_CH) { na = na_n; w4 = w4_n; b4 = b4_n; k4 = k4_n; r4 = r4_n; vv = vv_n; } }
            } else {
                if (c + 1 < SC_NCH) { st_emit(c + 1); if (c + 2 < SC_NCH) st_load(c + 2); }
                if (c >= 1) st_flush(c - 1);
            }
            __syncthreads();
        }
        if (wave >= 4) st_flush(SC_NCH - 1);
        __builtin_amdgcn_s_setprio(0);
        if (wave < 4) { float* sp = a.out + O_PWKV + ((size_t)(b * 16 + h) * 64 + vrow) * 64 + 4 * kq; *(f32x4*)sp = (f32x4){S01[0], S01[1], S23[0], S23[1]}; }
    }
    __syncthreads();
    { LAS float* vs = (LAS float*)(C.lds + wave * 16384);
      for (int it = C.gw; it < NSAMP * 16; it += C.ngw) { const int bs = it >> 4, hs = it & 15, kg = lane & 15, v_l = lane >> 4, hk = hs * 64 + 4 * kg; const size_t m = MP + bs;
        Ops o; prep_ops<true>(o, PRW + m * NRWP, a.in[I_SSHIFT] + (size_t)bs * NRW, LWW + m * 1024, LWA + m * 1024, rc, hk);
        if (v_l == 0) *(LAS f32x4*)(vs + 4 * kg) = o.v;
        LDS_WAIT(); asm volatile("" ::: "memory");
        const float* s0 = a.in[I_SWKV] + (size_t)(bs * 16 + hs) * 4096; float* s1 = a.out + O_SWKV + (size_t)(bs * 16 + hs) * 4096;
#pragma unroll 4
        for (int i = 0; i < 16; ++i) { const int row = 4 * i + v_l; const f32x4 S4 = *(const f32x4*)(s0 + row * 64 + 4 * kg);
            const float sa = red16(dot4(S4, o.na)); const float vv = vs[row];
            const f32x4 Sn = S4 * o.w + (o.b * sa + o.kp * vv);
            *(f32x4*)(s1 + row * 64 + 4 * kg) = Sn;
            const float ov = red16(dot4(Sn, o.r));
            if (kg == 0) ORAW[m * 1024 + hs * 64 + row] = ov; }
        LDS_WAIT(); asm volatile("" ::: "memory"); } }
}

__device__ __forceinline__ void phase_post(const Ctx& C, const Args& a) {
    unsigned char* ws = a.ws;
    const float* PRW = (const float*)(ws + WS_PRW); const float* ZROW = (const float*)(ws + WS_CTL) + CW_ZROW; const float* LWA = (const float*)(ws + WS_LWA);
    const bf16* LWG = (const bf16*)(ws + WS_LWG); const float* ORAW = (const float*)(ws + WS_ORAW); bf16* OMIX = (bf16*)(ws + WS_OMIX);
    const RwConst rc{a.in[I_MU], a.in[I_KK], a.in[I_KA]};
    const int kg = C.lane & 15;
    for (int g = C.gw * 4 + (C.lane >> 4); g < MV * 16; g += C.ngw * 4) { const int m = g >> 4, h = g & 15, hk = h * 64 + 4 * kg;
        const float* prow = PRW + (size_t)m * NRWP; const float* pprev = m < MP ? ((m & 2047) ? prow - NRWP : ZROW) : a.in[I_SSHIFT] + (size_t)(m - MP) * NRW;
        Ops o; prep_ops<false>(o, prow, pprev, nullptr, LWA + (size_t)m * 1024, rc, hk);
        const f32x4 rk = *(const f32x4*)(a.in[I_RK] + hk);
        const float sb = red16(dot4(o.r * o.kp, rk));
        const f32x4 o4 = *(const f32x4*)(ORAW + (size_t)m * 1024 + hk);
        const float mean = red16((o4[0] + o4[1]) + (o4[2] + o4[3])) * (1.0f / 64.0f); const f32x4 d = o4 - mean;
        const float var = red16(dot4(d, d)) * (1.0f / 64.0f); const float rstd = 1.0f / sqrtf(var + 64e-5f);
        const f32x4 lg = *(const f32x4*)(a.in[I_LNG] + hk), lb = *(const f32x4*)(a.in[I_LNB] + hk);
        const v2u gw2 = *(const v2u*)(LWG + (size_t)m * 1024 + hk); const f32x4 g4 = (f32x4){bflo(gw2.x), bfhi(gw2.x), bflo(gw2.y), bfhi(gw2.y)};
        const f32x4 res = (d * rstd * lg + lb + o.v * sb) * g4;
        v2u ov; ov.x = pk2(res[0], res[1]); ov.y = pk2(res[2], res[3]); *(v2u*)(OMIX + (size_t)m * DM + hk) = ov; }
}
__device__ __forceinline__ void phase_reduce(const Ctx& C, const Args& a, int nsl, const float* xin_s, float scale, float* ssq) {
    const float* slab = (const float*)(a.ws + WS_PRW); bf16* XB = (bf16*)(a.ws + WS_XB);
    for (int it = C.gw; it < NSAMP * 8; it += C.ngw) { const int r = it >> 3, col = (it & 7) * 256 + 4 * C.lane;
        f32x4 s = (f32x4){0.f, 0.f, 0.f, 0.f};
        for (int sl = 0; sl < nsl; ++sl) s += *(const f32x4*)(slab + ((size_t)sl * 128 + r) * DM + col);
        const f32x4 x = *(const f32x4*)(xin_s + (size_t)r * DM + col) + s * scale;
        *(f32x4*)(a.out + (size_t)(MP + r) * DM + col) = x;
        v2u o; o.x = pk2(x[0], x[1]); o.y = pk2(x[2], x[3]); *(v2u*)(XB + (size_t)(MP + r) * DM + col) = o;
        const float ss = wave_sum(dot4(x, x)); if (C.lane == 0) atomicAdd(ssq + MP + r, ss); }
}
__device__ __forceinline__ void phase_final(const Ctx& C, const Args& a, int nsl) {
    const float* ss4 = (const float*)(a.ws + WS_CTL) + CW_SS + 3 * SS_STRIDE; const float* gf = a.in[I_NF];
    for (int m = C.gw; m < MP; m += C.ngw) { const float rs = 1.0f / sqrtf(ss4[m] * (1.0f / 2048.0f) + 1e-6f); f32x4* xr = (f32x4*)(a.out + (size_t)m * DM);
#pragma unroll
        for (int j = 0; j < 8; ++j) { const f32x4 v = xr[C.lane + 64 * j], g = *((const f32x4*)gf + C.lane + 64 * j); xr[C.lane + 64 * j] = v * rs * g; } }
    const float* slab = (const float*)(a.ws + WS_PRW); LAS float* red = (LAS float*)C.lds;
    for (int r = blockIdx.x; r < NSAMP; r += gridDim.x) { const int col = 4 * C.tid;
        f32x4 s = (f32x4){0.f, 0.f, 0.f, 0.f};
        for (int sl = 0; sl < nsl; ++sl) s += *(const f32x4*)(slab + ((size_t)sl * 128 + r) * DM + col);
        f32x4* xp = (f32x4*)(a.out + (size_t)(MP + r) * DM + col); const f32x4 x = *xp + s * 0.5f;
        const float ws_ = wave_sum(dot4(x, x));
        __syncthreads(); if (C.lane == 0) red[C.wave] = ws_; __syncthreads();
        float tot = 0.f;
#pragma unroll
        for (int w = 0; w < NWAVES; ++w) tot += red[w];
        const float rs = 1.0f / sqrtf(tot * (1.0f / 2048.0f) + 1e-6f);
        *xp = x * rs * *(const f32x4*)(gf + col); }
}
__global__ void __launch_bounds__(NWAVES * 64, 2) mk_fwd(Args a_kernarg) {
    const Args& a = *(const Args*)__builtin_amdgcn_kernarg_segment_ptr();
    extern __shared__ __attribute__((aligned(16))) unsigned char lds_raw[];
    Ctx C; C.lds = (LAS unsigned char*)lds_raw; C.tid = threadIdx.x; C.lane = C.tid & 63; C.wave = __builtin_amdgcn_readfirstlane(C.tid >> 6);
    const int G = gridDim.x, bx = blockIdx.x, vcu = (G % 8 == 0) ? (bx % 8) * (G / 8) + bx / 8 : bx;
    C.gw = vcu * NWAVES + C.wave; C.ngw = G * NWAVES;
    volatile LAS unsigned* MISC = (volatile LAS unsigned*)(C.lds + MISC_OFF);
    for (int u = C.tid; u < (LDS_BYTES - LDSCTL_OFF) / 4; u += NWAVES * 64) ((LAS unsigned*)(C.lds + LDSCTL_OFF))[u] = 0u;
    __syncthreads();
    unsigned char* ws = a.ws; unsigned* ctl = (unsigned*)(ws + WS_CTL);
    const int lo = a.ph_lo, hi = a.ph_hi;
    XcdBarrier bar; bar.bar = ctl + CW_BAR; bar.x = 0; bar.st = nullptr;
    if (hi - lo > 1) bar = xcd_barrier_post(ctl + CW_BAR, MISC + 8);
#ifndef PH_MASK
#define PH_MASK 0x3FFF
#endif
#define IN(k) (((PH_MASK >> (k)) & 1) && lo <= (k) && (k) < hi)
#define SEAM(k) do { if (IN(k) && IN((k) + 1)) xcd_barrier(bar); } while (0)
#ifndef DUP_MASK
#define DUP_MASK 0
#endif
#define DUP(k) (((DUP_MASK >> (k)) & 1) != 0)
    float* ssb = (float*)ctl + CW_SS;
    bf16* XB = (bf16*)(ws + WS_XB); bf16* HB = (bf16*)(ws + WS_H); bf16* OMIX = (bf16*)(ws + WS_OMIX);
    LAS unsigned char* ring = C.lds;

    if (IN(0)) { for (int rep = 0; rep < (DUP(0) ? 2 : 1); ++rep) { if (rep) xcd_barrier(bar); phase_prologue(C, a); } SEAM(0); }
    if (IN(1)) {
#ifndef GEMM1_DUP
#define GEMM1_DUP 1
#endif
        pg8::Gemm g{XB, (const bf16*)(ws + WS_W1T), MPAD, 2 * FF, DM}; pg8::DupOrder S; S.init(MPAD, 2 * FF, DM, G, bx); S.rep = GEMM1_DUP;
        pg8::EpiSwiglu E{HB, ssb, FF};
        pg8::gemm_phase<pg8::EpiSwiglu, pg8::DupOrder, true, true>(ring, g, S, E); SEAM(1); }
    if (IN(2)) {
        pg8::Gemm g{HB, (const bf16*)(ws + WS_W2T), MPAD, DM, FF}; pg8::SliceOrder S; S.init(FF, G, bx);
        pg8::EpiResid E{a.in[I_XP], a.out, XB, ssb + SS_STRIDE, 0.5f, (float*)(ws + WS_PRW)};
        pg8::gemm_phase<pg8::EpiResid, pg8::SliceOrder, true, true>(ring, g, S, E); SEAM(2); }
    if (IN(3)) { phase_reduce(C, a, FF / 256, a.in[I_XS], 0.5f, ssb + SS_STRIDE); SEAM(3); }
    if (IN(4)) {
        pg8::Gemm g{XB, (const bf16*)(ws + WS_WINT), MPAD, NIN, DM}; pg8::StaticOrder S; S.init(MPAD, NIN, DM, G, bx);
        pg8::EpiWin E{(bf16*)(ws + WS_QKV), (float*)(ws + WS_PRW), ssb + SS_STRIDE, a.out + O_PKWIN, (long)(O_SKWIN - O_PKWIN), QSCALE};
        pg8::gemm_phase<pg8::EpiWin, pg8::StaticOrder, true, true>(ring, g, S, E); SEAM(4); }
    if (IN(5)) { for (int rep = 0; rep < (DUP(5) ? 2 : 1); ++rep) { if (rep) xcd_barrier(bar); phase_mixprep(C, a); } SEAM(5); }
    if (IN(6)) {
        pg8::Gemm g{(const bf16*)(ws + WS_ALORA), (const bf16*)(ws + WS_WLT), MPAD, NL, KL}; pg8::StaticOrder S; S.init(MPAD, NL, KL, G, bx);
        pg8::EpiLora E{(float*)(ws + WS_LWW), (long)((WS_LWA - WS_LWW) / 4), (bf16*)(ws + WS_LWG), a.in[I_DBASE], (long)(a.in[I_IBASE] - a.in[I_DBASE])};
        pg8::gemm_phase<pg8::EpiLora, pg8::StaticOrder, true, true>(ring, g, S, E); SEAM(6); }
    if (IN(7)) { for (int rep = 0; rep < (DUP(7) ? 2 : 1); ++rep) { if (rep) xcd_barrier(bar); phase_scan(C, a); } SEAM(7); }
    if (IN(8)) { for (int rep = 0; rep < (DUP(8) ? 2 : 1); ++rep) { if (rep) xcd_barrier(bar); phase_post(C, a); } SEAM(8); }
    if (IN(9)) {
        pg8::Gemm g{OMIX, (const bf16*)(ws + WS_WOUTT), MPAD, DM, DM}; pg8::SliceOrder S; S.init(DM, G, bx);
        pg8::EpiResid E{a.out, a.out, XB, ssb + 2 * SS_STRIDE, 1.0f, (float*)(ws + WS_PRW)};
        pg8::gemm_phase<pg8::EpiResid, pg8::SliceOrder, true, true>(ring, g, S, E); SEAM(9); }
    if (IN(10)) { phase_reduce(C, a, DM / 256, a.out + (size_t)MP * DM, 1.0f, ssb + 2 * SS_STRIDE); SEAM(10); }
    if (IN(11)) {
        pg8::Gemm g{XB, (const bf16*)(ws + WS_W1T), MPAD, 2 * FF, DM}; pg8::StaticOrder S; S.init(MPAD, 2 * FF, DM, G, bx);
        pg8::EpiSwiglu E{HB, ssb + 2 * SS_STRIDE, FF};
        pg8::gemm_phase<pg8::EpiSwiglu, pg8::StaticOrder, true, true>(ring, g, S, E); SEAM(11); }
    if (IN(12)) {
        pg8::Gemm g{HB, (const bf16*)(ws + WS_W2T), MPAD, DM, FF}; pg8::SliceOrder S; S.init(FF, G, bx);
        pg8::EpiResid E{a.out, a.out, nullptr, ssb + 3 * SS_STRIDE, 0.5f, (float*)(ws + WS_PRW)};
        pg8::gemm_phase<pg8::EpiResid, pg8::SliceOrder, true, true>(ring, g, S, E); SEAM(12); }
    if (IN(13)) { phase_final(C, a, FF / 256); }
#undef IN
#undef SEAM
}

extern "C" void kernel_launch(void* const* d_in, const int* in_sizes, int n_in, void* d_out, int out_size, void* d_ws, size_t ws_size, hipStream_t stream) {
    static int grid = 0;
    if (grid == 0) {
        if (n_in != 30 || out_size != (int)O_END || ws_size < WS_END) { fprintf(stderr, "kernel_launch: unexpected shapes: n_in %d out %d ws %zu (need %zu)\n", n_in, out_size, ws_size, (size_t)WS_END); grid = -1; return; }
        int dev = 0, cus = 0;
        if (hipGetDevice(&dev) != hipSuccess || hipDeviceGetAttribute(&cus, hipDeviceAttributeMultiprocessorCount, dev) != hipSuccess) { grid = -1; return; }
        if (hipFuncSetAttribute((const void*)mk_fwd, hipFuncAttributeMaxDynamicSharedMemorySize, LDS_BYTES) != hipSuccess) { fprintf(stderr, "kernel_launch: hipFuncSetAttribute failed\n"); grid = -1; return; }
        int per_cu = 0;
        if (hipOccupancyMaxActiveBlocksPerMultiprocessor(&per_cu, (const void*)mk_fwd, NWAVES * 64, LDS_BYTES) != hipSuccess || per_cu < 1) fprintf(stderr, "kernel_launch: occupancy query says %d\n", per_cu);
        (void)hipGetLastError();
        grid = cus;
    }
    if (grid < 0) return;
    if (hipMemsetAsync((char*)d_ws + WS_CTL, 0, CTL_ZERO_BYTES, stream) != hipSuccess) { fprintf(stderr, "kernel_launch: memset failed\n"); return; }
    Args a{};
    for (int i = 0; i < 30; ++i) a.in[i] = (const float*)d_in[i];
    a.out = (float*)d_out; a.ws = (unsigned char*)d_ws;
    if (MK_N_LAUNCHES == 1) { a.ph_lo = 0; a.ph_hi = N_PHASES; hipLaunchKernelGGL(mk_fwd, dim3(grid), dim3(NWAVES * 64), LDS_BYTES, stream, a); }
    else for (int p = 0; p < N_PHASES; ++p) { a.ph_lo = p; a.ph_hi = p + 1; hipLaunchKernelGGL(mk_fwd, dim3(grid), dim3(NWAVES * 64), LDS_BYTES, stream, a); }
    const hipError_t le = hipPeekAtLastError();
    if (le != hipSuccess) fprintf(stderr, "kernel_launch: launch failed: %s\n", hipGetErrorName(le));
}
```

```cpp
#include <hip/hip_runtime.h>
#include <cstdio>
#include <cstdint>
#define MK_N_LAUNCHES 1
namespace pg8 {
#define PG8_LAS __attribute__((address_space(3)))
typedef unsigned short bf16_t;
typedef short bf16x8 __attribute__((ext_vector_type(8)));
typedef float f32x4 __attribute__((ext_vector_type(4)));
typedef unsigned u32x4 __attribute__((ext_vector_type(4)));
constexpr int BM = 256, BK = 64, HALF = 128, HTB = HALF * BK * 2  , STAGE_BYTES = 8 * HTB, NXCD = 8, WGM = 8;

__host__ __device__ __forceinline__ int lds_byte(int r, int c) { const int st = (r >> 4) * 2 + (c >> 5), rr = r & 15, cc = c & 31, ob = rr * 64 + cc * 2; return st * 1024 + (ob ^ (((ob >> 9) & 1) << 5)); }
__host__ __device__ __forceinline__ void stage_rc(int b, int& R, int& C) { const int st = b / 1024, sb = b % 1024, swz = sb ^ (((sb >> 9) & 1) << 5); R = (st >> 1) * 16 + swz / 64; C = (st & 1) * 32 + (swz % 64) / 2; }
__host__ __device__ __forceinline__ int perm32(int rho) { const int n = rho >> 4, i = rho & 15; return 8 * (i >> 2) + 4 * n + (i & 3); }

struct Unit { int pm, pn, k0, nt, kind; };
struct Gemm { const bf16_t* A; const bf16_t* Bt; int M, N, K; };

struct StaticOrder {
    int nM, nN, nwg, G, c, ntf;
    __host__ __device__ void init(int M, int N, int K, int G_, int c_) { nM = M / BM; nN = N / BM; nwg = nM * nN; G = G_; c = c_; ntf = K / BK; }
    __host__ __device__ bool next(int i, Unit& u) const {
        const long L = (long)i * G + c; if (L >= nwg) return false;
        int wgid = (int)L; { const int q = nwg / NXCD, r = nwg % NXCD, xcd = wgid % NXCD, off = wgid / NXCD; wgid = (xcd < r ? xcd * (q + 1) : r * (q + 1) + (xcd - r) * q) + off; }
        const int nig = WGM * nN, gid = wgid / nig, fm = gid * WGM, gsz = (nM - fm) < WGM ? (nM - fm) : WGM;
        u.pm = fm + ((wgid % nig) % gsz); u.pn = (wgid % nig) / gsz; u.k0 = 0; u.nt = ntf; u.kind = 0; return true;
    }
    __device__ __forceinline__ void a_ready(const Unit&) const {}
    __device__ __forceinline__ void done(const Unit&) const {}
};
struct DupOrder : StaticOrder { int rep; __host__ __device__ bool next(int i, Unit& u) const { return StaticOrder::next(i / rep, u); } };
struct SliceOrder : StaticOrder {
    int nsl;
    __host__ __device__ void init(int K, int G_, int c_) { StaticOrder::init(8192, 2048, K, G_, c_); nsl = ntf / 4; }
    __host__ __device__ bool next(int i, Unit& u) const {
        const long L = (long)i * G + c;
        if (L < nwg) return StaticOrder::next(i, u);
        const int j = (int)(L - nwg); if (j >= 8 * nsl) return false;
        const int sl = j >> 3; u.pm = 32; u.pn = j & 7; u.k0 = 4 * sl; u.nt = (sl == nsl - 1) ? ntf - 4 * sl : 4; u.kind = 1; return true;
    }
};

__device__ __forceinline__ unsigned cvt_pk_bf16(float lo, float hi) { unsigned r; asm volatile("v_cvt_pk_bf16_f32 %0, %1, %2" : "=v"(r) : "v"(lo), "v"(hi)); return r; }
typedef unsigned u32x2 __attribute__((ext_vector_type(2)));
constexpr int MVALID = 8320, MPROMPT = 8192, DMODEL = 2048;
__device__ __forceinline__ float rs_row(const float* ss, int row) { return __builtin_amdgcn_rsqf(ss[row] * (1.0f / 2048.0f) + 1e-6f); }
__device__ __forceinline__ float silu_mul(float g, float u) { return g * u * __builtin_amdgcn_rcpf(1.0f + __builtin_amdgcn_exp2f(-1.4426950408889634f * g)); }
__device__ __forceinline__ float sigmoid_f(float x) { return __builtin_amdgcn_rcpf(1.0f + __builtin_amdgcn_exp2f(-1.4426950408889634f * x)); }

struct EpiSwiglu {
    static constexpr bool PERM = true, AFTER_DRAIN = false;
    bf16_t* H; const float* ss; int ldh;
    __device__ __forceinline__ void operator()(const f32x4 (&acc)[2][2][4][2], const Unit& u, int wr, int wc, int fr, int fq) const {
        const int row0 = u.pm * BM + wr * 64 + fr, col0 = u.pn * HALF + wc * 32 + 8 * fq;
#pragma unroll
        for (int ai = 0; ai < 2; ++ai)
#pragma unroll
            for (int m = 0; m < 4; ++m) { const int row = row0 + ai * HALF + m * 16; const float rs = rs_row(ss, row);
                const f32x4 g0 = acc[ai][0][m][0] * rs, g1 = acc[ai][0][m][1] * rs, u0 = acc[ai][1][m][0] * rs, u1 = acc[ai][1][m][1] * rs;
                u32x4 w; w.x = cvt_pk_bf16(silu_mul(g0[0], u0[0]), silu_mul(g0[1], u0[1])); w.y = cvt_pk_bf16(silu_mul(g0[2], u0[2]), silu_mul(g0[3], u0[3]));
                w.z = cvt_pk_bf16(silu_mul(g1[0], u1[0]), silu_mul(g1[1], u1[1])); w.w = cvt_pk_bf16(silu_mul(g1[2], u1[2]), silu_mul(g1[3], u1[3]));
                *(u32x4*)(H + (size_t)row * ldh + col0) = w; }
    }
};
struct EpiResid {
    static constexpr bool PERM = true, AFTER_DRAIN = false;
    const float* xin; float* xout; bf16_t* xb; float* ssq; float scale; float* slab;
    __device__ __forceinline__ void operator()(const f32x4 (&acc)[2][2][4][2], const Unit& u, int wr, int wc, int fr, int fq) const {
        const int col0 = u.pn * BM + wc * 32 + 8 * fq;
        if (u.kind == 0) {
            const int row0 = u.pm * BM + wr * 64 + fr;
#pragma unroll
            for (int ai = 0; ai < 2; ++ai)
#pragma unroll
                for (int m = 0; m < 4; ++m) { const int row = row0 + ai * HALF + m * 16; const size_t off = (size_t)row * DMODEL + col0;
                    float part = 0.f;
#pragma unroll
                    for (int bj = 0; bj < 2; ++bj) { const f32x4 x0 = *(const f32x4*)(xin + off + bj * HALF), x1 = *(const f32x4*)(xin + off + bj * HALF + 4);
                        const f32x4 v0 = x0 + acc[ai][bj][m][0] * scale, v1 = x1 + acc[ai][bj][m][1] * scale;
                        part += (v0[0] * v0[0] + v0[1] * v0[1]) + (v0[2] * v0[2] + v0[3] * v0[3]) + (v1[0] * v1[0] + v1[1] * v1[1]) + (v1[2] * v1[2] + v1[3] * v1[3]);
                        *(f32x4*)(xout + off + bj * HALF) = v0; *(f32x4*)(xout + off + bj * HALF + 4) = v1;
                        if (xb) { u32x4 w; w.x = cvt_pk_bf16(v0[0], v0[1]); w.y = cvt_pk_bf16(v0[2], v0[3]); w.z = cvt_pk_bf16(v1[0], v1[1]); w.w = cvt_pk_bf16(v1[2], v1[3]);
                            *(u32x4*)(xb + off + bj * HALF) = w; } }
                    part += __shfl_xor(part, 16); part += __shfl_xor(part, 32);
                    if (fq == 0) atomicAdd(ssq + row, part); }
        } else {
            float* sb = slab + ((size_t)(u.k0 >> 2) * 128 + wr * 64 + fr) * DMODEL + col0;
#pragma unroll
            for (int m = 0; m < 4; ++m)
#pragma unroll
                for (int bj = 0; bj < 2; ++bj) { float* o = sb + (size_t)(m * 16) * DMODEL + bj * HALF; *(f32x4*)o = acc[0][bj][m][0]; *(f32x4*)(o + 4) = acc[0][bj][m][1]; }
        }
    }
};
struct EpiWin {
    static constexpr bool PERM = true, AFTER_DRAIN = false;
    bf16_t* QKV; float* PRW; const float* ss; float* kwin_p; long wins_minus_winp; float qscale;
    __device__ __forceinline__ void operator()(const f32x4 (&acc)[2][2][4][2], const Unit& u, int wr, int wc, int fr, int fq) const {
        const int row0 = u.pm * BM + wr * 64 + fr, c0 = wc * 32 + 8 * fq;
#pragma unroll
        for (int ai = 0; ai < 2; ++ai)
#pragma unroll
            for (int m = 0; m < 4; ++m) { const int row = row0 + ai * HALF + m * 16; const float rs = rs_row(ss, row);
#pragma unroll
                for (int bj = 0; bj < 2; ++bj) { const f32x4 v0 = acc[ai][bj][m][0] * rs, v1 = acc[ai][bj][m][1] * rs; const int c256 = bj * HALF + c0;
                    if (u.pn < 6) { const float sc = u.pn < 4 ? qscale : 1.0f;
                        u32x4 w; w.x = cvt_pk_bf16(v0[0] * sc, v0[1] * sc); w.y = cvt_pk_bf16(v0[2] * sc, v0[3] * sc); w.z = cvt_pk_bf16(v1[0] * sc, v1[1] * sc); w.w = cvt_pk_bf16(v1[2] * sc, v1[3] * sc);
                        *(u32x4*)(QKV + (size_t)row * 1536 + u.pn * BM + c256) = w;
                        if (u.pn >= 4) { long off = -1; const bool isp = row < MPROMPT; const long kv = u.pn - 4;
                            if (isp) { const int t = row & 2047; if (t >= 1920) off = kv * 131072 + (long)((row >> 11) * 128 + (t - 1920)) * 256 + c256; }
                            else if (row < MVALID) off = (long)(wins_minus_winp) + kv * 4194304 + (long)((row - MPROMPT) * 128 + 127) * 256 + c256;
                            if (off >= 0) { *(f32x4*)(kwin_p + off) = v0; *(f32x4*)(kwin_p + off + 4) = v1; } }
                    } else { float* o = PRW + (size_t)row * 3584 + (u.pn - 6) * BM + c256; *(f32x4*)o = v0; *(f32x4*)(o + 4) = v1; } } }
    }
};
struct EpiLora {
    static constexpr bool PERM = true, AFTER_DRAIN = false;
    float* LWW; long lwa_minus_lww; bf16_t* LWG; const float* dbase; long ibase_minus_dbase;
    __device__ __forceinline__ void operator()(const f32x4 (&acc)[2][2][4][2], const Unit& u, int wr, int wc, int fr, int fq) const {
        const int row0 = u.pm * BM + wr * 64 + fr, seg = u.pn >> 2, cb = (u.pn & 3) * BM + wc * 32 + 8 * fq;
#pragma unroll
        for (int bj = 0; bj < 2; ++bj) { const int col = cb + bj * HALF;
            f32x4 b0 = (f32x4){0.f, 0.f, 0.f, 0.f}, b1 = b0;
            if (seg < 2) { const float* bp = dbase + (seg ? ibase_minus_dbase : 0) + col; b0 = *(const f32x4*)bp; b1 = *(const f32x4*)(bp + 4); }
#pragma unroll
            for (int ai = 0; ai < 2; ++ai)
#pragma unroll
                for (int m = 0; m < 4; ++m) { const int row = row0 + ai * HALF + m * 16; const f32x4 v0 = acc[ai][bj][m][0] + b0, v1 = acc[ai][bj][m][1] + b1;
                    if (seg == 2) { u32x4 w; w.x = cvt_pk_bf16(v0[0], v0[1]); w.y = cvt_pk_bf16(v0[2], v0[3]); w.z = cvt_pk_bf16(v1[0], v1[1]); w.w = cvt_pk_bf16(v1[2], v1[3]);
                        *(u32x4*)(LWG + (size_t)row * 1024 + col) = w; }
                    else { float* o = LWW + (seg ? lwa_minus_lww : 0) + (size_t)row * 1024 + col; *(f32x4*)o = v0; *(f32x4*)(o + 4) = v1; } } }
    }
};
template <class Epi, class Sched, bool ALIGN_EPI = false, bool SP2 = false>
__device__ __forceinline__ void gemm_phase(PG8_LAS unsigned char* lds, const Gemm g, const Sched& S, const Epi& E) {
    const int tid = threadIdx.x, wid = __builtin_amdgcn_readfirstlane(tid >> 6), lane = tid & 63, wr = wid >> 2, wc = wid & 3, fr = lane & 15, fq = lane >> 4;
    const int K = g.K;
    unsigned voffA[2], voffB[2];
#pragma unroll
    for (int i = 0; i < 2; ++i) { int R, C; stage_rc(tid * 16 + i * 8192, R, C); const int Rb = Epi::PERM ? ((R & ~31) + perm32(R & 31)) : R;
        voffA[i] = (unsigned)(R * K + C) * 2u; voffB[i] = (unsigned)(Rb * K + C) * 2u; }
    const size_t kstep = (size_t)(BK * 2);
    const size_t hstep = (size_t)HALF * K * 2;
    const size_t tstep = 2 * hstep;
    const unsigned ldsw = (unsigned)wid * 1024u;
    const int aoff = lds_byte(wr * 64 + fr, fq * 8), boff = lds_byte(wc * 32 + fr, fq * 8);
#define PG8_SA(b, h) (((b) * 2 + (h)) * HTB)
#define PG8_SB(b, h) ((4 + (b) * 2 + (h)) * HTB)
#define PG8_STAGE(bufoff, gbase, voff) do { _Pragma("unroll") for (int _i = 0; _i < 2; ++_i) \
        __builtin_amdgcn_global_load_lds((const unsigned*)((const char*)(gbase) + (voff)[_i]), (PG8_LAS unsigned*)(lds + (bufoff) + ldsw + _i * 8192), 16, 0, 0); } while (0)
#define PG8_LDA(dst, b, h) do { _Pragma("unroll") for (int m = 0; m < 4; ++m) _Pragma("unroll") for (int k = 0; k < 2; ++k) dst[m][k] = *(const PG8_LAS bf16x8*)(lds + PG8_SA(b, h) + aoff + m * 2048 + k * 1024); } while (0)
#define PG8_LDB(dst, b, h) do { _Pragma("unroll") for (int n = 0; n < 2; ++n) _Pragma("unroll") for (int k = 0; k < 2; ++k) dst[n][k] = *(const PG8_LAS bf16x8*)(lds + PG8_SB(b, h) + boff + n * 2048 + k * 1024); } while (0)
#define PG8_MMA(ai, bj, At, Bt) do { __builtin_amdgcn_s_setprio(1); _Pragma("unroll") for (int m = 0; m < 4; ++m) _Pragma("unroll") for (int n = 0; n < 2; ++n) _Pragma("unroll") for (int k = 0; k < 2; ++k) \
        acc[ai][bj][m][n] = __builtin_amdgcn_mfma_f32_16x16x32_bf16(Bt[n][k], At[m][k], acc[ai][bj][m][n], 0, 0, 0); __builtin_amdgcn_s_setprio(0); } while (0)
#define PG8_WAIT_V(n) asm volatile("s_waitcnt vmcnt(" #n ")" ::: "memory")
#define PG8_WAIT_L(n) asm volatile("s_waitcnt lgkmcnt(" #n ")" ::: "memory")
#define PG8_BAR __builtin_amdgcn_s_barrier()
#define PG8_SCHED __builtin_amdgcn_sched_barrier(0)
    Unit cur, nxt; int ui = 0;
    if (!S.next(0, cur)) return;
    f32x4 acc[2][2][4][2];
#pragma unroll
    for (int a = 0; a < 2; ++a)
#pragma unroll
        for (int b = 0; b < 2; ++b)
#pragma unroll
            for (int m = 0; m < 4; ++m)
#pragma unroll
                for (int n = 0; n < 2; ++n) acc[a][b][m][n] = (f32x4){0.f, 0.f, 0.f, 0.f};
    bf16x8 At[4][2], B0[2][2], B1[2][2];
    const char* cA = (const char*)g.A + (size_t)cur.pm * tstep + (size_t)cur.k0 * kstep; const char* cB = (const char*)g.Bt + (size_t)cur.pn * tstep + (size_t)cur.k0 * kstep;
    S.a_ready(cur);
    if constexpr (SP2) {
        PG8_STAGE(PG8_SB(0, 0), cB, voffB); PG8_STAGE(PG8_SB(0, 1), cB + hstep, voffB); PG8_STAGE(PG8_SA(0, 0), cA, voffA); PG8_STAGE(PG8_SA(0, 1), cA + hstep, voffA);
        if (wr == 1) PG8_BAR;
        PG8_WAIT_V(2); PG8_BAR;
        PG8_STAGE(PG8_SB(1, 0), cB + kstep, voffB); PG8_STAGE(PG8_SA(1, 0), cA + kstep, voffA); PG8_STAGE(PG8_SB(1, 1), cB + hstep + kstep, voffB);
        PG8_WAIT_V(6); PG8_BAR;
    } else {
        PG8_STAGE(PG8_SB(0, 0), cB, voffB); PG8_STAGE(PG8_SA(0, 0), cA, voffA); PG8_STAGE(PG8_SB(0, 1), cB + hstep, voffB); PG8_STAGE(PG8_SA(0, 1), cA + hstep, voffA);
        if (wr == 1) PG8_BAR;
        PG8_WAIT_V(4); PG8_BAR;
        PG8_STAGE(PG8_SB(1, 0), cB + kstep, voffB); PG8_STAGE(PG8_SA(1, 0), cA + kstep, voffA); PG8_STAGE(PG8_SB(1, 1), cB + hstep + kstep, voffB);
        PG8_WAIT_V(6); PG8_BAR;
    }
    for (;;) {
        const bool has_next = S.next(ui + 1, nxt);
        const char* nA = has_next ? (const char*)g.A + (size_t)nxt.pm * tstep + (size_t)nxt.k0 * kstep : cA; const char* nB = has_next ? (const char*)g.Bt + (size_t)nxt.pn * tstep + (size_t)nxt.k0 * kstep : cB;
        const int nt = cur.nt;
#pragma unroll 1
        for (int t = 0; t < nt; t += 2) {
            const bool last = (t == nt - 2);
            const char* a1 = cA + (size_t)(t + 1) * kstep;
            const char* a2 = last ? nA : cA + (size_t)(t + 2) * kstep; const char* b2 = last ? nB : cB + (size_t)(t + 2) * kstep;
            const char* a3 = a2 + kstep; const char* b3 = b2 + kstep;
            if (last && has_next) S.a_ready(nxt);
            if constexpr (SP2) {
            PG8_LDB(B0, 0, 0); PG8_LDB(B1, 0, 1); PG8_SCHED; PG8_LDA(At, 0, 0); PG8_STAGE(PG8_SA(1, 1), a1 + hstep, voffA);
            PG8_WAIT_V(8); PG8_WAIT_L(0); PG8_BAR; PG8_MMA(0, 0, At, B0); PG8_MMA(0, 1, At, B1); PG8_BAR; PG8_SCHED;
            PG8_LDA(At, 0, 1); PG8_STAGE(PG8_SB(0, 0), b2, voffB); PG8_STAGE(PG8_SB(0, 1), b2 + hstep, voffB); PG8_STAGE(PG8_SA(0, 0), a2, voffA);
            PG8_WAIT_V(8); PG8_WAIT_L(0); PG8_BAR; PG8_MMA(1, 0, At, B0); PG8_MMA(1, 1, At, B1); PG8_BAR; PG8_SCHED;
            PG8_LDB(B0, 1, 0); PG8_LDB(B1, 1, 1); PG8_SCHED; PG8_LDA(At, 1, 0); PG8_STAGE(PG8_SA(0, 1), a2 + hstep, voffA);
            PG8_WAIT_V(8); PG8_WAIT_L(0); PG8_BAR; PG8_MMA(0, 0, At, B0); PG8_MMA(0, 1, At, B1); PG8_BAR; PG8_SCHED;
            PG8_LDA(At, 1, 1); PG8_STAGE(PG8_SB(1, 0), b3, voffB); PG8_STAGE(PG8_SB(1, 1), b3 + hstep, voffB); PG8_STAGE(PG8_SA(1, 0), a3, voffA);
            PG8_WAIT_V(8); PG8_WAIT_L(0); PG8_BAR; PG8_MMA(1, 0, At, B0); PG8_MMA(1, 1, At, B1); PG8_BAR; PG8_SCHED;
            } else {
            PG8_LDB(B0, 0, 0); PG8_SCHED; PG8_LDA(At, 0, 0); PG8_STAGE(PG8_SA(1, 1), a1 + hstep, voffA);
            PG8_WAIT_L(8); PG8_BAR; PG8_WAIT_L(0); PG8_MMA(0, 0, At, B0); PG8_BAR; PG8_SCHED;
            PG8_LDB(B1, 0, 1); PG8_STAGE(PG8_SB(0, 0), b2, voffB);
            PG8_BAR; PG8_WAIT_L(0); PG8_MMA(0, 1, At, B1); PG8_BAR;
            PG8_LDA(At, 0, 1); PG8_STAGE(PG8_SA(0, 0), a2, voffA);
            PG8_BAR; PG8_WAIT_L(0); PG8_MMA(1, 0, At, B0); PG8_BAR; PG8_SCHED;
            PG8_STAGE(PG8_SB(0, 1), b2 + hstep, voffB);
            PG8_WAIT_V(6); PG8_BAR; PG8_MMA(1, 1, At, B1); PG8_BAR;
            PG8_LDB(B0, 1, 0); PG8_SCHED; PG8_LDA(At, 1, 0); PG8_STAGE(PG8_SA(0, 1), a2 + hstep, voffA);
            PG8_WAIT_L(8); PG8_BAR; PG8_WAIT_L(0); PG8_MMA(0, 0, At, B0); PG8_BAR; PG8_SCHED;
            PG8_LDB(B1, 1, 1); PG8_STAGE(PG8_SB(1, 0), b3, voffB);
            PG8_BAR; PG8_WAIT_L(0); PG8_MMA(0, 1, At, B1); PG8_BAR;
            PG8_LDA(At, 1, 1); PG8_STAGE(PG8_SA(1, 0), a3, voffA);
            PG8_BAR; PG8_WAIT_L(0); PG8_MMA(1, 0, At, B0); PG8_BAR; PG8_SCHED;
            PG8_STAGE(PG8_SB(1, 1), b3 + hstep, voffB);
            PG8_WAIT_V(6); PG8_BAR; PG8_MMA(1, 1, At, B1); PG8_BAR;
            }
        }
        if constexpr (ALIGN_EPI) { if (wr == 0) PG8_BAR; }
        if constexpr (!Epi::AFTER_DRAIN) { E(acc, cur, wr, wc, fr, fq); S.done(cur); }
        if (!has_next) break;
#pragma unroll
        for (int a = 0; a < 2; ++a)
#pragma unroll
            for (int b = 0; b < 2; ++b)
#pragma unroll
                for (int m = 0; m < 4; ++m)
#pragma unroll
                    for (int n = 0; n < 2; ++n) acc[a][b][m][n] = (f32x4){0.f, 0.f, 0.f, 0.f};
        cur = nxt; cA = nA; cB = nB; ++ui;
        if constexpr (ALIGN_EPI) { if (wr == 1) PG8_BAR; }
    }
    PG8_WAIT_V(0);
    if constexpr (!ALIGN_EPI) { if (wr == 0) PG8_BAR; }
    PG8_BAR;
    if constexpr (Epi::AFTER_DRAIN) { E.fused(acc, cur, wr, wc, fr, fq, lds, wid, lane); S.done(cur); }
#undef PG8_SA
#undef PG8_SB
#undef PG8_STAGE
#undef PG8_LDA
#undef PG8_LDB
#undef PG8_MMA
#undef PG8_WAIT_V
#undef PG8_WAIT_L
#undef PG8_BAR
#undef PG8_SCHED
}
}

constexpr int NWAVES = 8;
#ifndef MK_N_LAUNCHES
#define MK_N_LAUNCHES 1
#endif
constexpr int N_PHASES = 14;
constexpr int DM = 2048, TSEQ = 2048, NBATCH = 4, MP = 8192, NSAMP = 128, MV = 8320, MPAD = 8448, FF = 5504, NQKV = 1536, NRW = 3360, NRWP = 3584, NIN = 5120, KL = 384, NL = 3072;
using pg8::sigmoid_f;
constexpr float QSCALE = 0.125f * 1.4426950408889634f, LOG2E = 1.4426950408889634f;
constexpr size_t O_YP = 0, O_YS = 16777216, O_PSHIFT = 17039360, O_PWKV = 17052800, O_PKWIN = 17314944, O_PVWIN = 17446016, O_SSHIFT = 17577088, O_SWKV = 18007168, O_SKWIN = 26395776, O_SVWIN = 30590080, O_END = 34784384;
constexpr size_t MiB = 1u << 20;
constexpr size_t WS_CTL = 0, CTL_ZERO_BYTES = 1 * MiB;
constexpr size_t WS_W1T = 1 * MiB, WS_W2T = 44 * MiB, WS_WINT = 66 * MiB, WS_WOUTT = 86 * MiB, WS_WLT = 94 * MiB, WS_XB = 97 * MiB, WS_H = 130 * MiB, WS_PRW = 219 * MiB, WS_QKV = 335 * MiB, WS_OMIX = 360 * MiB, WS_END = 393 * MiB;
constexpr size_t WS_LWW = WS_H, WS_LWA = WS_H + (size_t)MPAD * 1024 * 4, WS_LWG = WS_H + (size_t)MPAD * 1024 * 8, WS_ALORA = WS_H + (size_t)MPAD * 1024 * 10;
constexpr size_t WS_ORAW = WS_XB;
static_assert(WS_ALORA + (size_t)MPAD * KL * 2 <= WS_H + (size_t)MPAD * FF * 2 && WS_H + (size_t)MPAD * FF * 2 <= WS_PRW && WS_PRW + (size_t)MPAD * NRWP * 4 <= WS_QKV && WS_QKV + (size_t)MPAD * NQKV * 2 <= WS_OMIX && WS_OMIX + (size_t)MPAD * DM * 2 <= WS_END, "ws map");
static_assert(WS_W1T + (size_t)2 * FF * DM * 2 <= WS_W2T && WS_W2T + (size_t)FF * DM * 2 <= WS_WINT && WS_WINT + (size_t)NIN * DM * 2 <= WS_WOUTT && WS_WOUTT + (size_t)DM * DM * 2 <= WS_WLT && WS_WLT + (size_t)NL * KL * 2 <= WS_XB && WS_XB + (size_t)MPAD * DM * 2 <= WS_H, "ws map 2");
constexpr int CW_BAR = 4096, CW_SS = 16384, SS_STRIDE = 16384, CW_ZROW = 131072;
constexpr int RING_BYTES = 131072, LDSCTL_OFF = RING_BYTES, MISC_OFF = LDSCTL_OFF + 320, LDS_BYTES = 147456;

#define GAS __attribute__((address_space(1)))
#define LAS __attribute__((address_space(3)))
typedef unsigned short bf16;
typedef unsigned v4u __attribute__((ext_vector_type(4)));
typedef unsigned v2u __attribute__((ext_vector_type(2)));
typedef float f32x4 __attribute__((ext_vector_type(4)));
typedef short bf16x8 __attribute__((ext_vector_type(8)));
typedef short s16x4 __attribute__((ext_vector_type(4)));
#define LDS_WAIT() asm volatile("s_waitcnt lgkmcnt(0)" ::: "memory")
#define VM_WAIT() asm volatile("s_waitcnt vmcnt(0)" ::: "memory")
__device__ __forceinline__ unsigned f2bf(float f) { unsigned u = __builtin_bit_cast(unsigned, f); return (u + 0x7fffu + ((u >> 16) & 1u)) >> 16; }
__device__ __forceinline__ unsigned pk2(float lo, float hi) { return f2bf(lo) | (f2bf(hi) << 16); }
__device__ __forceinline__ float bf2f(unsigned short b) { return __builtin_bit_cast(float, (unsigned)b << 16); }
__device__ __forceinline__ float bflo(unsigned w) { return __builtin_bit_cast(float, w << 16); }
__device__ __forceinline__ float bfhi(unsigned w) { return __builtin_bit_cast(float, w & 0xffff0000u); }
#define XB_TMO      128
#define XB_XCNT(j)  (256  + 64 * (j))
#define XB_XSUB(j)  (1280 + 64 * (j))
#define XB_XGEN(j)  (2304 + 64 * (j))
#define XB_TOP      3328
#define XB_TOPGEN   3392
#define XCD_BAR_WORDS 3456
#define XB_SPIN_CAP (1u << 18)

__device__ __forceinline__ unsigned xb_ld(unsigned* p)              { return __hip_atomic_load(p, __ATOMIC_RELAXED, __HIP_MEMORY_SCOPE_AGENT); }
__device__ __forceinline__ unsigned xb_add(unsigned* p, unsigned v) { return __hip_atomic_fetch_add(p, v, __ATOMIC_RELAXED, __HIP_MEMORY_SCOPE_AGENT); }
__device__ __forceinline__ unsigned xb_xcc_id() { return (unsigned)__builtin_amdgcn_s_getreg((3 << 11) | 20) & 0xFu; }
#define XB_SPIN(cond, bar) do { unsigned _sp = 0; while (cond) { __builtin_amdgcn_s_sleep(1); \
    if ((++_sp & 255u) == 0u) { if (xb_ld(&(bar)[XB_TMO])) break; if (_sp > XB_SPIN_CAP) { atomicAdd(&(bar)[XB_TMO], 1u); break; } } } } while (0)

struct XcdBarrier {
    unsigned* bar; unsigned x;
    volatile LAS unsigned* st;
};

__device__ __forceinline__ XcdBarrier xcd_barrier_post(unsigned* bar, volatile LAS unsigned* st) {
    XcdBarrier b; b.bar = bar; b.x = xb_xcc_id(); b.st = st;
    if (threadIdx.x == 0) (void)xb_add(&bar[XB_XCNT(b.x)], 1u);
    return b;
}
__device__ __forceinline__ void xcd_barrier_complete(unsigned* bar, unsigned x, unsigned& nloc, unsigned& nx) {
    const unsigned G = gridDim.x * gridDim.y * gridDim.z;
    unsigned sum, cnt, mine, sp = 0u;
    for (;;) {
        sum = 0u; cnt = 0u; mine = 0u;
#pragma unroll
        for (unsigned j = 0; j < 16; ++j) { const unsigned c = xb_ld(&bar[XB_XCNT(j)]); sum += c; cnt += (c > 0u) ? 1u : 0u; mine = (j == x) ? c : mine; }
        if (sum == G) break;
        __builtin_amdgcn_s_sleep(1);
        if ((++sp & 255u) == 0u) { if (xb_ld(&bar[XB_TMO])) break; if (sp > XB_SPIN_CAP) { atomicAdd(&bar[XB_TMO], 1u); break; } }
    }
    nloc = mine > 0u ? mine : 1u; nx = cnt > 0u ? cnt : 1u;
}

__device__ __forceinline__ void xcd_barrier(const XcdBarrier& b) {
    asm volatile("s_waitcnt vmcnt(0)" ::: "memory");
    __syncthreads();
    if (threadIdx.x == 0) {
        unsigned* bar = b.bar;
        __builtin_amdgcn_s_waitcnt(0);
        unsigned nloc = b.st[0], nx = b.st[1];
        if (nloc == 0u) { xcd_barrier_complete(bar, b.x, nloc, nx); b.st[0] = nloc; b.st[1] = nx; }
        const unsigned old = xb_add(&bar[XB_XSUB(b.x)], 1u);
        const unsigned gen = old / nloc;
        if (old + 1u == (gen + 1u) * nloc) {
            __builtin_amdgcn_fence(__ATOMIC_RELEASE, "agent");
            asm volatile("s_waitcnt vmcnt(0)" ::: "memory");
            const unsigned og = xb_add(&bar[XB_TOP], 1u);
            const unsigned tg = og / nx;
            if (og + 1u == (tg + 1u) * nx) xb_add(&bar[XB_TOPGEN], 1u);
            else XB_SPIN(xb_ld(&bar[XB_TOPGEN]) == tg, bar);
            __builtin_amdgcn_fence(__ATOMIC_ACQUIRE, "agent");
            xb_add(&bar[XB_XGEN(b.x)], 1u);
            asm volatile("s_waitcnt vmcnt(0)" ::: "memory");
        } else {
            XB_SPIN(xb_ld(&bar[XB_XGEN(b.x)]) == gen, bar);
            __builtin_amdgcn_fence(__ATOMIC_ACQUIRE, "agent");
            asm volatile("s_waitcnt vmcnt(0)" ::: "memory");
        }
    }
    __syncthreads();
}
struct Args { const float* in[30]; float* out; unsigned char* ws; int ph_lo, ph_hi; };
enum { I_XP = 0, I_XS, I_SSHIFT, I_SWKV, I_CK, I_CV, I_N1, I_W1G, I_W1U, I_W1D, I_NMIX, I_WIN, I_MU, I_DUP, I_DBASE, I_IUP, I_IBASE, I_GUP, I_KK, I_KA, I_RK, I_LNG, I_LNB, I_SINK, I_WOUT, I_N2, I_W2G, I_W2U, I_W2D, I_NF };

struct Ctx { LAS unsigned char* lds; int tid, lane, wave, gw, ngw; };

template <int CTRL> __device__ __forceinline__ float dpp_f(float x) { return __builtin_bit_cast(float, __builtin_amdgcn_mov_dpp(__builtin_bit_cast(int, x), CTRL, 0xf, 0xf, true)); }
__device__ __forceinline__ float red8(float x) { x += dpp_f<0xB1>(x); x += dpp_f<0x4E>(x); x += dpp_f<0x141>(x); return x; }
__device__ __forceinline__ float red16(float x) { x = red8(x); x += dpp_f<0x140>(x); return x; }
__device__ __forceinline__ float wave_sum(float v) {
#pragma unroll
    for (int o = 1; o < 64; o <<= 1) v += __shfl_xor(v, o);
    return v;
}
__device__ __forceinline__ float wave_max(float v) {
#pragma unroll
    for (int o = 1; o < 64; o <<= 1) v = fmaxf(v, __shfl_xor(v, o));
    return v;
}
__device__ __forceinline__ float dot4(f32x4 a, f32x4 b) { return (a[0] * b[0] + a[1] * b[1]) + (a[2] * b[2] + a[3] * b[3]); }

struct TrSpec { const float* W; int K, N; const float* gain; bf16* WT; int mode; };
struct TrRegs { f32x4 v[16]; };
__device__ __forceinline__ void tr_load(TrRegs& R, const TrSpec& S, int item, int lane) {
    const int nblk = (S.N + 63) / 64, kb = item / nblk, nb = item % nblk, k0 = 64 * kb, n0 = 64 * nb, kl = lane >> 4, nq = lane & 15; const bool ld_ok = n0 + 4 * nq < S.N;
    const float* src = S.W + (size_t)(k0 + kl) * S.N + n0 + 4 * nq;
#pragma unroll
    for (int i = 0; i < 16; ++i) { R.v[i] = (f32x4){0.f, 0.f, 0.f, 0.f}; if (ld_ok) R.v[i] = *(const f32x4*)(src + (size_t)(4 * i) * S.N); }
}
__device__ __forceinline__ unsigned cvtpk(float lo, float hi) { unsigned r; asm volatile("v_cvt_pk_bf16_f32 %0, %1, %2" : "=v"(r) : "v"(lo), "v"(hi)); return r; }
__device__ __forceinline__ void tr_store(const TrRegs& R, const TrSpec& S, LAS float* scr, int item, int lane) {
    const int nblk = (S.N + 63) / 64, kb = item / nblk, nb = item % nblk, k0 = 64 * kb, n0 = 64 * nb, kl = lane >> 4, nq = lane & 15;
#pragma unroll
    for (int i = 0; i < 16; ++i) { const int k = 4 * i + kl; f32x4 x = R.v[i]; if (S.gain) x = x * S.gain[k0 + k];
        *(LAS f32x4*)(scr + k * 64 + 4 * (nq ^ ((k >> 3) & 7))) = x; }
    LDS_WAIT(); asm volatile("" ::: "memory");
    const int c = lane & 7;
#pragma unroll
    for (int j = 0; j < 8; ++j) { const int n = (lane >> 3) + 8 * j; const LAS float* s = scr + (8 * c) * 64 + 4 * ((n >> 2) ^ c) + (n & 3);
        v4u o; o.x = cvtpk(s[0 * 64], s[1 * 64]); o.y = cvtpk(s[2 * 64], s[3 * 64]); o.z = cvtpk(s[4 * 64], s[5 * 64]); o.w = cvtpk(s[6 * 64], s[7 * 64]);
        const int ng = n0 + n; const int row = S.mode == 0 ? ng : (256 * (ng >> 7) + (ng & 127) + (S.mode == 2 ? 128 : 0));
        if (ng < S.N) *(v4u*)(S.WT + (size_t)row * S.K + k0 + 8 * c) = o; }
    LDS_WAIT(); asm volatile("" ::: "memory");
}
struct TrList { TrSpec s[5]; int cnt[5]; int n; };
__device__ __forceinline__ int tr_find(const TrList& T, int it, int& local) { int r = it, q = 0;
#pragma unroll
    for (int i = 0; i < 4; ++i) if (q == i && i + 1 < T.n && r >= T.cnt[i]) { r -= T.cnt[i]; q = i + 1; }
    local = r; return q; }
constexpr int CONV_SPLIT = 3400;
__device__ __forceinline__ void tr_run(const Ctx& C, const TrList& T, int first, int stride, int lo = 0, int hi = 1 << 30) {
    LAS float* scr = (LAS float*)(C.lds + C.wave * 16384);
    int total = 0;
#pragma unroll
    for (int i = 0; i < 5; ++i) if (i < T.n) total += T.cnt[i];
    if (hi < total) total = hi;
    int it = lo + first; if (it >= total) return;
    TrRegs cur; int lc; int q = tr_find(T, it, lc);
#pragma unroll
    for (int i = 0; i < 5; ++i) if (i == q) tr_load(cur, T.s[i], lc, C.lane);
#pragma unroll 1
    for (;;) { const int nit = it + stride; TrRegs nxt; int ln = 0, qn = -1;
        if (nit < total) { qn = tr_find(T, nit, ln);
#pragma unroll
            for (int i = 0; i < 5; ++i) if (i == qn) tr_load(nxt, T.s[i], ln, C.lane); }
#pragma unroll
        for (int i = 0; i < 5; ++i) if (i == q) tr_store(cur, T.s[i], scr, lc, C.lane);
        if (nit >= total) break;
        cur = nxt; it = nit; q = qn; lc = ln; }
}
__device__ __forceinline__ void convert_ffn(const Ctx& C, const float* Wg, const float* Wu, const float* Wd, const float* gain, bf16* W1T, bf16* W2T, int first, int stride, int lo = 0, int hi = 1 << 30) {
    TrList T; T.n = 3;
    T.s[0] = TrSpec{Wg, DM, FF, gain, W1T, 1}; T.cnt[0] = (DM / 64) * (FF / 64);
    T.s[1] = TrSpec{Wu, DM, FF, gain, W1T, 2}; T.cnt[1] = (DM / 64) * (FF / 64);
    T.s[2] = TrSpec{Wd, FF, DM, nullptr, W2T, 0}; T.cnt[2] = (FF / 64) * (DM / 64);
    T.s[3] = T.s[2]; T.s[4] = T.s[2]; T.cnt[3] = 0; T.cnt[4] = 0;
    tr_run(C, T, first, stride, lo, hi);
}

__device__ __forceinline__ void phase_prologue(const Ctx& C, const Args& a) {
    unsigned char* ws = a.ws;
    {   TrList T; T.n = 5;
        T.s[0] = TrSpec{a.in[I_W1G], DM, FF, a.in[I_N1], (bf16*)(ws + WS_W1T), 1}; T.cnt[0] = (DM / 64) * (FF / 64);
        T.s[1] = TrSpec{a.in[I_W1U], DM, FF, a.in[I_N1], (bf16*)(ws + WS_W1T), 2}; T.cnt[1] = (DM / 64) * (FF / 64);
        T.s[2] = TrSpec{a.in[I_W1D], FF, DM, nullptr, (bf16*)(ws + WS_W2T), 0}; T.cnt[2] = (FF / 64) * (DM / 64);
        T.s[3] = TrSpec{a.in[I_WIN], DM, 4896, a.in[I_NMIX], (bf16*)(ws + WS_WINT), 0}; T.cnt[3] = (DM / 64) * ((4896 + 63) / 64);
        T.s[4] = TrSpec{a.in[I_WOUT], DM, DM, nullptr, (bf16*)(ws + WS_WOUTT), 0}; T.cnt[4] = (DM / 64) * (DM / 64);
        tr_run(C, T, C.gw, C.ngw); }
    {
        v4u* z = (v4u*)((bf16*)(ws + WS_WINT) + (size_t)4896 * DM);
        for (int i = C.gw * 64 + C.lane; i < 224 * DM / 8; i += C.ngw * 64) z[i] = (v4u){0u, 0u, 0u, 0u};
    }
    {
        unsigned* WL = (unsigned*)(ws + WS_WLT);
        for (int e = C.gw * 64 + C.lane; e < (KL / 2) * NL; e += C.ngw * 64) { const int kp = e / NL, n = e % NL; float v[2];
#pragma unroll
            for (int i = 0; i < 2; ++i) { const int k = 2 * kp + i; v[i] = 0.f;
                if (n < 1024) { if (k < 64) v[i] = a.in[I_DUP][k * 1024 + n]; }
                else if (n < 2048) { if (k >= 64 && k < 128) v[i] = a.in[I_IUP][(k - 64) * 1024 + (n - 1024)]; }
                else { if (k >= 128 && k < 288) v[i] = a.in[I_GUP][(k - 128) * 1024 + (n - 2048)]; } }
            WL[((size_t)n * KL + 2 * kp) / 2] = pk2(v[0], v[1]); }
    }
    {
        bf16* XB = (bf16*)(ws + WS_XB); float* ss1 = (float*)(ws + WS_CTL) + CW_SS;
        for (int m = C.gw; m < MPAD; m += C.ngw) {
            const float* xr = m < MP ? a.in[I_XP] + (size_t)m * DM : a.in[I_XS] + (size_t)(m - MP) * DM;
            float s = 0.f;
#pragma unroll
            for (int j = 0; j < 8; ++j) { f32x4 v = (f32x4){0.f, 0.f, 0.f, 0.f}; if (m < MV) v = *((const f32x4*)xr + C.lane + 64 * j);
                s += dot4(v, v); v2u o; o.x = pk2(v[0], v[1]); o.y = pk2(v[2], v[3]); *((v2u*)(XB + (size_t)m * DM) + C.lane + 64 * j) = o; }
            s = wave_sum(s); if (C.lane == 0) ss1[m] = s;
        }
    }
}

struct Ops { f32x4 na, w, b, kp, r, v; };
__device__ __forceinline__ f32x4 sig4(f32x4 x) { return (f32x4){sigmoid_f(x[0]), sigmoid_f(x[1]), sigmoid_f(x[2]), sigmoid_f(x[3])}; }
__device__ __forceinline__ f32x4 decay4(f32x4 x) { const f32x4 s = sig4(x); return (f32x4){__builtin_amdgcn_exp2f(-0.8750387749f * s[0]), __builtin_amdgcn_exp2f(-0.8750387749f * s[1]), __builtin_amdgcn_exp2f(-0.8750387749f * s[2]), __builtin_amdgcn_exp2f(-0.8750387749f * s[3])}; }
struct RwConst { const float* mu; const float* k_k; const float* k_a; };
template <bool WITH_W> __device__ __forceinline__ void prep_ops(Ops& o, const float* prow, const float* pprev, const float* wrow, const float* arow, const RwConst& rc, int hk) {
    const f32x4 pr = *(const f32x4*)(prow + hk), pk = *(const f32x4*)(prow + 1024 + hk), pv = *(const f32x4*)(prow + 2048 + hk);
    const f32x4 qr = *(const f32x4*)(pprev + hk), qk = *(const f32x4*)(pprev + 1024 + hk), qv = *(const f32x4*)(pprev + 2048 + hk);
    const f32x4 mr = *(const f32x4*)(rc.mu + hk), mk = *(const f32x4*)(rc.mu + 1024 + hk), mv = *(const f32x4*)(rc.mu + 2048 + hk);
    const f32x4 a4 = sig4(*(const f32x4*)(arow + hk)), kk4 = *(const f32x4*)(rc.k_k + hk), ka4 = *(const f32x4*)(rc.k_a + hk);
    const f32x4 ur = pr + mr * (qr - pr), uk = pk + mk * (qk - pk), uv = pv + mv * (qv - pv);
    const f32x4 kk = uk * kk4;
    const float n2 = red16(dot4(kk, kk));
    const float inv = 1.0f / fmaxf(sqrtf(n2), 1e-12f);
    const f32x4 kkn = kk * inv;
    o.na = -kkn; o.b = kkn * a4; o.kp = uk * (1.0f + (a4 - 1.0f) * ka4); o.r = ur; o.v = uv;
    if (WITH_W) o.w = decay4(*(const f32x4*)(wrow + hk)); else o.w = (f32x4){0.f, 0.f, 0.f, 0.f};
}

typedef short v4i16_t __attribute__((ext_vector_type(4)));
constexpr int AT_STRIDE = 160, AT_ROWS = 272, AT_KOFF = 0, AT_VOFF = AT_ROWS * AT_STRIDE, AT_END = 2 * AT_ROWS * AT_STRIDE;
__device__ __forceinline__ void attn_prompt_unit(const Ctx& C, const Args& a, int unit) {
    const bf16* QKV = (const bf16*)(a.ws + WS_QKV); bf16* OMIX = (bf16*)(a.ws + WS_OMIX);
    const int b = unit >> 6, nb = (unit >> 2) & 15, c = unit & 3;
    const int m0 = b * TSEQ + nb * 128;
    LAS unsigned char* Kt = C.lds + AT_KOFF; LAS unsigned char* Vt = C.lds + AT_VOFF;
    __syncthreads();
    for (int i = C.tid; i < 2 * AT_ROWS * 8; i += 512) { const int which = i / (AT_ROWS * 8), r = (i % (AT_ROWS * 8)) >> 3, ch = i & 7;
        v4u v = (v4u){0u, 0u, 0u, 0u};
        if (r < 256 && (nb > 0 || r >= 128)) v = *(const v4u*)(QKV + (size_t)(m0 - 128 + r) * NQKV + 1024 + which * 256 + c * 64 + ch * 8);
        *(LAS v4u*)((which ? Vt : Kt) + r * AT_STRIDE + ch * 16) = v; }
    __syncthreads();
    const int w = C.wave, fr = C.lane & 15, fq = C.lane >> 4;
#pragma unroll 1
    for (int hq = 0; hq < 4; ++hq) { const int h = 4 * c + hq;
        const float slope2 = __builtin_amdgcn_exp2f(-0.5f * (float)(h + 1)) * LOG2E, sink2 = a.in[I_SINK][h] * LOG2E;
        const bf16* qp = QKV + (size_t)(m0 + 16 * w + fr) * NQKV + h * 64 + 8 * fq;
        const bf16x8 q0 = *(const bf16x8*)qp, q1 = *(const bf16x8*)(qp + 32);
        f32x4 s[10];
#pragma unroll
        for (int kt = 0; kt < 10; ++kt) { const LAS unsigned char* kp = Kt + (16 * (w + kt) + fr) * AT_STRIDE + 16 * fq;
            const bf16x8 k0 = *(const LAS bf16x8*)kp, k1 = *(const LAS bf16x8*)(kp + 64);
            f32x4 acc = (f32x4){0.f, 0.f, 0.f, 0.f};
            acc = __builtin_amdgcn_mfma_f32_16x16x32_bf16(k0, q0, acc, 0, 0, 0); acc = __builtin_amdgcn_mfma_f32_16x16x32_bf16(k1, q1, acc, 0, 0, 0);
            s[kt] = acc; }
        const int qi = 16 * w + fr; float mx = sink2;
#pragma unroll
        for (int kt = 0; kt < 10; ++kt)
#pragma unroll
            for (int r = 0; r < 4; ++r) { const int kj = 16 * (w + kt) + 4 * fq + r, dist = 128 + qi - kj; const bool ok = dist >= 0 && dist < 128 && (nb > 0 || kj >= 128);
                const float v = ok ? s[kt][r] - slope2 * (float)dist : -1e30f; s[kt][r] = v; mx = fmaxf(mx, v); }
        mx = fmaxf(mx, __shfl_xor(mx, 16)); mx = fmaxf(mx, __shfl_xor(mx, 32));
        float sum = 0.f;
#pragma unroll
        for (int kt = 0; kt < 10; ++kt)
#pragma unroll
            for (int r = 0; r < 4; ++r) { const float p = __builtin_amdgcn_exp2f(s[kt][r] - mx); s[kt][r] = p; sum += p; }
        sum += __shfl_xor(sum, 16); sum += __shfl_xor(sum, 32);
        const float inv = 1.0f / (sum + __builtin_amdgcn_exp2f(sink2 - mx));
        f32x4 o[4];
#pragma unroll
        for (int dt = 0; dt < 4; ++dt) o[dt] = (f32x4){0.f, 0.f, 0.f, 0.f};
#pragma unroll
        for (int st = 0; st < 5; ++st) {
            union { bf16x8 v; unsigned u[4]; } pb;
            pb.u[0] = pk2(s[2 * st][0], s[2 * st][1]); pb.u[1] = pk2(s[2 * st][2], s[2 * st][3]); pb.u[2] = pk2(s[2 * st + 1][0], s[2 * st + 1][1]); pb.u[3] = pk2(s[2 * st + 1][2], s[2 * st + 1][3]);
#pragma unroll
            for (int dt = 0; dt < 4; ++dt) {
                const LAS unsigned char* vp = Vt + (16 * (w + 2 * st) + 4 * fq + (fr >> 2)) * AT_STRIDE + (16 * dt + 4 * (fr & 3)) * 2;
                const v4i16_t t0 = __builtin_amdgcn_ds_read_tr16_b64_v4i16((LAS v4i16_t*)vp), t1 = __builtin_amdgcn_ds_read_tr16_b64_v4i16((LAS v4i16_t*)(vp + 16 * AT_STRIDE));
                bf16x8 va; va[0] = t0[0]; va[1] = t0[1]; va[2] = t0[2]; va[3] = t0[3]; va[4] = t1[0]; va[5] = t1[1]; va[6] = t1[2]; va[7] = t1[3];
                o[dt] = __builtin_amdgcn_mfma_f32_16x16x32_bf16(va, pb.v, o[dt], 0, 0, 0); } }
        bf16* op = OMIX + (size_t)(m0 + 16 * w + fr) * DM + 1024 + h * 64 + 4 * fq;
#pragma unroll
        for (int dt = 0; dt < 4; ++dt) { v2u ov; ov.x = pk2(o[dt][0] * inv, o[dt][1] * inv); ov.y = pk2(o[dt][2] * inv, o[dt][3] * inv); *(v2u*)(op + 16 * dt) = ov; }
    }
}
__device__ __forceinline__ void attn_sample_item(const Ctx& C, const Args& a, int item, LAS float* scr  ) {
    const bf16* QKV = (const bf16*)(a.ws + WS_QKV); bf16* OMIX = (bf16*)(a.ws + WS_OMIX);
    const int b = item >> 2, c = item & 3, lane = C.lane; const int mrow = MP + b;
    LAS float* qs = scr; LAS float* ps = scr + 256;
#pragma unroll
    for (int hq = 0; hq < 4; ++hq) qs[hq * 64 + lane] = bf2f(QKV[(size_t)mrow * NQKV + (4 * c + hq) * 64 + lane]);
    LDS_WAIT(); asm volatile("" ::: "memory");
    const float* ck = a.in[I_CK] + ((size_t)b * 128 * 4 + c) * 64; const float* cv = a.in[I_CV] + ((size_t)b * 128 * 4 + c) * 64;
    float* kw = a.out + O_SKWIN + ((size_t)b * 128 * 4 + c) * 64; float* vw = a.out + O_SVWIN + ((size_t)b * 128 * 4 + c) * 64;
#pragma unroll 1
    for (int jj = 0; jj < 2; ++jj) { const int j = lane + 64 * jj;
        float d0 = 0.f, d1 = 0.f, d2 = 0.f, d3 = 0.f;
#pragma unroll 1
        for (int hf = 0; hf < 2; ++hf) { f32x4 kv[8]; const float* kr = ck + (size_t)j * 256 + 32 * hf; float* kwr = kw + (size_t)(j - 1) * 256 + 32 * hf; const LAS float* qh = qs + 32 * hf;
#pragma unroll
            for (int d4 = 0; d4 < 8; ++d4) kv[d4] = *(const f32x4*)(kr + 4 * d4);
#pragma unroll
            for (int d4 = 0; d4 < 8; ++d4) { if (j >= 1) *(f32x4*)(kwr + 4 * d4) = kv[d4];
                d0 += dot4(kv[d4], *(const LAS f32x4*)(qh + 0 * 64 + 4 * d4)); d1 += dot4(kv[d4], *(const LAS f32x4*)(qh + 1 * 64 + 4 * d4));
                d2 += dot4(kv[d4], *(const LAS f32x4*)(qh + 2 * 64 + 4 * d4)); d3 += dot4(kv[d4], *(const LAS f32x4*)(qh + 3 * 64 + 4 * d4)); } }
        ps[0 * 132 + j] = d0; ps[1 * 132 + j] = d1; ps[2 * 132 + j] = d2; ps[3 * 132 + j] = d3; }
    { const float kn = bf2f(QKV[(size_t)mrow * NQKV + 1024 + c * 64 + lane]);
      const float e0 = wave_sum(kn * qs[lane]), e1 = wave_sum(kn * qs[64 + lane]), e2 = wave_sum(kn * qs[128 + lane]), e3 = wave_sum(kn * qs[192 + lane]);
      if (lane == 0) { ps[0 * 132 + 128] = e0; ps[1 * 132 + 128] = e1; ps[2 * 132 + 128] = e2; ps[3 * 132 + 128] = e3; } }
    LDS_WAIT(); asm volatile("" ::: "memory");
#pragma unroll 1
    for (int hq = 0; hq < 4; ++hq) { const int h = 4 * c + hq;
        const float slope2 = __builtin_amdgcn_exp2f(-0.5f * (float)(h + 1)) * LOG2E, sink2 = a.in[I_SINK][h] * LOG2E;
        const float v0 = lane >= 1 ? ps[hq * 132 + lane] - slope2 * (float)(128 - lane) : -1e30f;
        const float v1 = ps[hq * 132 + 64 + lane] - slope2 * (float)(64 - lane);
        const float v2 = ps[hq * 132 + 128];
        const float mx = wave_max(fmaxf(fmaxf(v0, v1), fmaxf(v2, sink2)));
        const float p0 = __builtin_amdgcn_exp2f(v0 - mx), p1 = __builtin_amdgcn_exp2f(v1 - mx), p2 = __builtin_amdgcn_exp2f(v2 - mx);
        const float tot = wave_sum(p0 + p1) + p2 + __builtin_amdgcn_exp2f(sink2 - mx); const float inv = 1.0f / tot;
        LDS_WAIT(); asm volatile("" ::: "memory");
        ps[hq * 132 + lane] = p0 * inv; ps[hq * 132 + 64 + lane] = p1 * inv; if (lane == 0) ps[hq * 132 + 128] = p2 * inv; }
    LDS_WAIT(); asm volatile("" ::: "memory");
    float o0 = 0.f, o1 = 0.f, o2 = 0.f, o3 = 0.f;
#pragma unroll 1
    for (int jb = 0; jb < 128; jb += 16) { float vv[16];
#pragma unroll
        for (int i = 0; i < 16; ++i) vv[i] = cv[(size_t)(jb + i) * 256 + lane];
#pragma unroll
        for (int i = 0; i < 16; ++i) { const int j = jb + i; if (j >= 1) vw[(size_t)(j - 1) * 256 + lane] = vv[i];
            o0 += ps[0 * 132 + j] * vv[i]; o1 += ps[1 * 132 + j] * vv[i]; o2 += ps[2 * 132 + j] * vv[i]; o3 += ps[3 * 132 + j] * vv[i]; } }
    { const float vv = bf2f(QKV[(size_t)mrow * NQKV + 1280 + c * 64 + lane]);
      o0 += ps[0 * 132 + 128] * vv; o1 += ps[1 * 132 + 128] * vv; o2 += ps[2 * 132 + 128] * vv; o3 += ps[3 * 132 + 128] * vv; }
    bf16* op = OMIX + (size_t)mrow * DM + 1024 + (4 * c) * 64 + lane;
    op[0] = (bf16)f2bf(o0); op[64] = (bf16)f2bf(o1); op[128] = (bf16)f2bf(o2); op[192] = (bf16)f2bf(o3);
    LDS_WAIT(); asm volatile("" ::: "memory");
}
__device__ __forceinline__ void phase_mixprep(const Ctx& C, const Args& a) {
    unsigned char* ws = a.ws;
    const float* PRW = (const float*)(ws + WS_PRW); const float* ZROW = (const float*)(ws + WS_CTL) + CW_ZROW;
#ifndef MIX_DUP
#define MIX_DUP 0
#endif
    for (int rep = 0; rep < ((MIX_DUP & 1) ? 2 : 1); ++rep)
    for (int unit = blockIdx.x; unit < 256; unit += gridDim.x) attn_prompt_unit(C, a, unit);
    __syncthreads();
    for (int rep = 0; rep < ((MIX_DUP & 2) ? 2 : 1); ++rep)
    for (int it = C.gw; it < NSAMP * 4; it += C.ngw) attn_sample_item(C, a, it, (LAS float*)(C.lds + C.wave * 16384));
    { bf16* AL = (bf16*)(ws + WS_ALORA); const float* mu = a.in[I_MU] + 3072;
      for (int m = C.gw; m < MPAD; m += C.ngw) {
        const float* prow = PRW + (size_t)m * NRWP + 3072;
        const float* pprev = m < MP ? ((m & 2047) ? prow - NRWP : ZROW) : (m < MV ? a.in[I_SSHIFT] + (size_t)(m - MP) * NRW + 3072 : ZROW);
#pragma unroll
        for (int jj = 0; jj < 6; ++jj) { const int j = C.lane + 64 * jj; float v = 0.f;
            if (j < 288 && m < MV) { const float p = prow[j]; const float u = p + mu[j] * (pprev[j] - p);
                v = j < 64 ? (2.0f * sigmoid_f(2.0f * u) - 1.0f) : (j < 128 ? u : sigmoid_f(u)); }
            AL[(size_t)m * KL + j] = (bf16)f2bf(v); } } }
    for (int r = C.gw; r < NBATCH + NSAMP; r += C.ngw) {
        const float* src = PRW + (size_t)(r < NBATCH ? r * TSEQ + TSEQ - 1 : MP + (r - NBATCH)) * NRWP;
        float* dst = r < NBATCH ? a.out + O_PSHIFT + (size_t)r * NRW : a.out + O_SSHIFT + (size_t)(r - NBATCH) * NRW;
        for (int j = C.lane; j < NRW / 4; j += 64) *((f32x4*)dst + j) = *((const f32x4*)src + j); }
    for (int rep = 0; rep < ((MIX_DUP & 4) ? 2 : 1); ++rep)
    convert_ffn(C, a.in[I_W2G], a.in[I_W2U], a.in[I_W2D], a.in[I_N2], (bf16*)(ws + WS_W1T), (bf16*)(ws + WS_W2T), C.gw, C.ngw, CONV_SPLIT, 1 << 30);
}

constexpr int SC_CH = 16, SC_NCH = TSEQ / SC_CH, SC_OPB = SC_CH * 6 * 64, SC_OPART = SC_CH * 256;
typedef float f32x2 __attribute__((ext_vector_type(2)));
struct StRaw { f32x4 pr, pk, pv, qr, qk, qv, w, a; };
__device__ __forceinline__ void phase_scan(const Ctx& C, const Args& a) {
    unsigned char* ws = a.ws;
    const float* PRW = (const float*)(ws + WS_PRW); const float* ZROW = (const float*)(ws + WS_CTL) + CW_ZROW;
    const float* LWW = (const float*)(ws + WS_LWW); const float* LWA = (const float*)(ws + WS_LWA); float* ORAW = (float*)(ws + WS_ORAW);
    const RwConst rc{a.in[I_MU], a.in[I_KK], a.in[I_KA]};
    LAS float* opb = (LAS float*)C.lds; LAS float* opart = (LAS float*)(C.lds + 2 * SC_OPB * 4);
    const int wave = C.wave, lane = C.lane;
    for (int item = blockIdx.x; item < 256; item += gridDim.x) {
        const int chain = item >> 2, qr = item & 3, b = chain >> 4, h = chain & 15;
        const size_t mbase = (size_t)b * TSEQ;
        const int st_id = (C.tid - 256) & 255, st_t = st_id >> 4, st_kg = lane & 15, hk = h * 64 + 4 * st_kg;
        const f32x4 mr = *(const f32x4*)(rc.mu + hk), mk = *(const f32x4*)(rc.mu + 1024 + hk), mv = *(const f32x4*)(rc.mu + 2048 + hk), kk4 = *(const f32x4*)(rc.k_k + hk), ka4 = *(const f32x4*)(rc.k_a + hk);
        StRaw raw;
        auto st_load = [&](int c) { const int t = c * SC_CH + st_t; const float* prow = PRW + (mbase + t) * NRWP; const float* pp = t ? prow - NRWP : ZROW;
            raw.pr = *(const f32x4*)(prow + hk); raw.pk = *(const f32x4*)(prow + 1024 + hk); raw.pv = *(const f32x4*)(prow + 2048 + hk);
            raw.qr = *(const f32x4*)(pp + hk); raw.qk = *(const f32x4*)(pp + 1024 + hk); raw.qv = *(const f32x4*)(pp + 2048 + hk);
            raw.w = *(const f32x4*)(LWW + (mbase + t) * 1024 + hk); raw.a = *(const f32x4*)(LWA + (mbase + t) * 1024 + hk); };
        auto st_emit = [&](int c) { LAS float* ob = opb + (c & 1) * SC_OPB + st_t * 384 + 4 * st_kg;
            const f32x4 ur = raw.pr + mr * (raw.qr - raw.pr), uk = raw.pk + mk * (raw.qk - raw.pk), uv = raw.pv + mv * (raw.qv - raw.pv);
            const f32x4 kk = uk * kk4; const float n2 = red16(dot4(kk, kk)); const float inv = 1.0f / fmaxf(sqrtf(n2), 1e-12f); const f32x4 kkn = kk * inv;
            const f32x4 aa = sig4(raw.a);
            *(LAS f32x4*)(ob + 0 * 64) = -kkn; *(LAS f32x4*)(ob + 1 * 64) = decay4(raw.w); *(LAS f32x4*)(ob + 2 * 64) = kkn * aa;
            *(LAS f32x4*)(ob + 3 * 64) = uk * (1.0f + (aa - 1.0f) * ka4); *(LAS f32x4*)(ob + 4 * 64) = ur; *(LAS f32x4*)(ob + 5 * 64) = uv; };
        auto st_flush = [&](int c) {
            const LAS float* pp = opart + (c & 1) * SC_OPART + st_id * 4;
#pragma unroll
            for (int i = 0; i < 4; ++i) { const f32x4 p0 = *(const LAS f32x4*)(pp + i * 1024); float s = (p0[0] + p0[1]) + (p0[2] + p0[3]);
                s += dpp_f<0xB1>(s); s += dpp_f<0x4E>(s);
                const int tr = i * 64 + (st_id >> 2);
                if ((st_id & 3) == 0) ORAW[(mbase + c * SC_CH + (tr >> 4)) * 1024 + h * 64 + 16 * qr + (tr & 15)] = s; } };
        const int row_l = lane >> 4, kq = lane & 15, vrow = 16 * qr + 4 * wave + row_l;
        f32x2 S01 = (f32x2){0.f, 0.f}, S23 = (f32x2){0.f, 0.f};
        __syncthreads();
        if (wave < 4) __builtin_amdgcn_s_setprio(3);
        if (wave >= 4) { st_load(0); st_emit(0); st_load(1); }
        __syncthreads();
#pragma unroll 1
        for (int c = 0; c < SC_NCH; ++c) {
            if (wave < 4) {
                const LAS float* ob = opb + (c & 1) * SC_OPB + 4 * kq; const LAS float* vb = opb + (c & 1) * SC_OPB + 320 + vrow;
                LAS float* oo = opart + (c & 1) * SC_OPART + (4 * wave + row_l) * 16 + kq;
                f32x4 na = *(const LAS f32x4*)(ob), w4 = *(const LAS f32x4*)(ob + 64), b4 = *(const LAS f32x4*)(ob + 128), k4 = *(const LAS f32x4*)(ob + 192), r4 = *(const LAS f32x4*)(ob + 256);
                float vv = vb[0];
#pragma unroll
                for (int t = 0; t < SC_CH; ++t) { const LAS float* p = ob + (t + 1) * 384;
                    f32x4 na_n, w4_n, b4_n, k4_n, r4_n; float vv_n;
                    if (t + 1 < SC_CH) { na_n = *(const LAS f32x4*)(p); w4_n = *(const LAS f32x4*)(p + 64); b4_n = *(const LAS f32x4*)(p + 128); k4_n = *(const LAS f32x4*)(p + 192); r4_n = *(const LAS f32x4*)(p + 256); vv_n = vb[(t + 1) * 384]; }
                    f32x2 d = S01 * (f32x2){na[0], na[1]}; d = S23 * (f32x2){na[2], na[3]} + d;
                    const float sa = red16(d[0] + d[1]);
                    const f32x2 vk01 = (f32x2){k4[0], k4[1]} * vv, vk23 = (f32x2){k4[2], k4[3]} * vv;
                    const f32x2 t01 = (f32x2){b4[0], b4[1]} * sa + vk01, t23 = (f32x2){b4[2], b4[3]} * sa + vk23;
                    S01 = S01 * (f32x2){w4[0], w4[1]} + t01; S23 = S23 * (f32x2){w4[2], w4[3]} + t23;
                    f32x2 e = S01 * (f32x2){r4[0], r4[1]}; e = S23 * (f32x2){r4[2], r4[3]} + e;
                    oo[t * 256] = e[0] + e[1];
                    if (t + 1 < SC_CH) { na = na_n; w4 = w4_n; b4 = b4_n; k4 = k4_n; r4 = r4_n; vv = vv_n; } }
            } else {
                if (c + 1 < SC_NCH) { st_emit(c + 1); if (c + 2 < SC_NCH) st_load(c + 2); }
                if (c >= 1) st_flush(c - 1);
            }
            __syncthreads();
        }
        if (wave >= 4) st_flush(SC_NCH - 1);
        __builtin_amdgcn_s_setprio(0);
        if (wave < 4) { float* sp = a.out + O_PWKV + ((size_t)(b * 16 + h) * 64 + vrow) * 64 + 4 * kq; *(f32x4*)sp = (f32x4){S01[0], S01[1], S23[0], S23[1]}; }
    }
    __syncthreads();
    { LAS float* vs = (LAS float*)(C.lds + wave * 16384);
      for (int it = C.gw; it < NSAMP * 16; it += C.ngw) { const int bs = it >> 4, hs = it & 15, kg = lane & 15, v_l = lane >> 4, hk = hs * 64 + 4 * kg; const size_t m = MP + bs;
        Ops o; prep_ops<true>(o, PRW + m * NRWP, a.in[I_SSHIFT] + (size_t)bs * NRW, LWW + m * 1024, LWA + m * 1024, rc, hk);
        if (v_l == 0) *(LAS f32x4*)(vs + 4 * kg) = o.v;
        LDS_WAIT(); asm volatile("" ::: "memory");
        const float* s0 = a.in[I_SWKV] + (size_t)(bs * 16 + hs) * 4096; float* s1 = a.out + O_SWKV + (size_t)(bs * 16 + hs) * 4096;
#pragma unroll 4
        for (int i = 0; i < 16; ++i) { const int row = 4 * i + v_l; const f32x4 S4 = *(const f32x4*)(s0 + row * 64 + 4 * kg);
            const float sa = red16(dot4(S4, o.na)); const float vv = vs[row];
            const f32x4 Sn = S4 * o.w + (o.b * sa + o.kp * vv);
            *(f32x4*)(s1 + row * 64 + 4 * kg) = Sn;
            const float ov = red16(dot4(Sn, o.r));
            if (kg == 0) ORAW[m * 1024 + hs * 64 + row] = ov; }
        LDS_WAIT(); asm volatile("" ::: "memory"); } }
}

__device__ __forceinline__ void phase_post(const Ctx& C, const Args& a) {
    unsigned char* ws = a.ws;
    const float* PRW = (const float*)(ws + WS_PRW); const float* ZROW = (const float*)(ws + WS_CTL) + CW_ZROW; const float* LWA = (const float*)(ws + WS_LWA);
    const bf16* LWG = (const bf16*)(ws + WS_LWG); const float* ORAW = (const float*)(ws + WS_ORAW); bf16* OMIX = (bf16*)(ws + WS_OMIX);
    const RwConst rc{a.in[I_MU], a.in[I_KK], a.in[I_KA]};
    const int kg = C.lane & 15;
    for (int g = C.gw * 4 + (C.lane >> 4); g < MV * 16; g += C.ngw * 4) { const int m = g >> 4, h = g & 15, hk = h * 64 + 4 * kg;
        const float* prow = PRW + (size_t)m * NRWP; const float* pprev = m < MP ? ((m & 2047) ? prow - NRWP : ZROW) : a.in[I_SSHIFT] + (size_t)(m - MP) * NRW;
        Ops o; prep_ops<false>(o, prow, pprev, nullptr, LWA + (size_t)m * 1024, rc, hk);
        const f32x4 rk = *(const f32x4*)(a.in[I_RK] + hk);
        const float sb = red16(dot4(o.r * o.kp, rk));
        const f32x4 o4 = *(const f32x4*)(ORAW + (size_t)m * 1024 + hk);
        const float mean = red16((o4[0] + o4[1]) + (o4[2] + o4[3])) * (1.0f / 64.0f); const f32x4 d = o4 - mean;
        const float var = red16(dot4(d, d)) * (1.0f / 64.0f); const float rstd = 1.0f / sqrtf(var + 64e-5f);
        const f32x4 lg = *(const f32x4*)(a.in[I_LNG] + hk), lb = *(const f32x4*)(a.in[I_LNB] + hk);
        const v2u gw2 = *(const v2u*)(LWG + (size_t)m * 1024 + hk); const f32x4 g4 = (f32x4){bflo(gw2.x), bfhi(gw2.x), bflo(gw2.y), bfhi(gw2.y)};
        const f32x4 res = (d * rstd * lg + lb + o.v * sb) * g4;
        v2u ov; ov.x = pk2(res[0], res[1]); ov.y = pk2(res[2], res[3]); *(v2u*)(OMIX + (size_t)m * DM + hk) = ov; }
}
__device__ __forceinline__ void phase_reduce(const Ctx& C, const Args& a, int nsl, const float* xin_s, float scale, float* ssq) {
    const float* slab = (const float*)(a.ws + WS_PRW); bf16* XB = (bf16*)(a.ws + WS_XB);
    for (int it = C.gw; it < NSAMP * 8; it += C.ngw) { const int r = it >> 3, col = (it & 7) * 256 + 4 * C.lane;
        f32x4 s = (f32x4){0.f, 0.f, 0.f, 0.f};
        for (int sl = 0; sl < nsl; ++sl) s += *(const f32x4*)(slab + ((size_t)sl * 128 + r) * DM + col);
        const f32x4 x = *(const f32x4*)(xin_s + (size_t)r * DM + col) + s * scale;
        *(f32x4*)(a.out + (size_t)(MP + r) * DM + col) = x;
        v2u o; o.x = pk2(x[0], x[1]); o.y = pk2(x[2], x[3]); *(v2u*)(XB + (size_t)(MP + r) * DM + col) = o;
        const float ss = wave_sum(dot4(x, x)); if (C.lane == 0) atomicAdd(ssq + MP + r, ss); }
}
__device__ __forceinline__ void phase_final(const Ctx& C, const Args& a, int nsl) {
    const float* ss4 = (const float*)(a.ws + WS_CTL) + CW_SS + 3 * SS_STRIDE; const float* gf = a.in[I_NF];
    for (int m = C.gw; m < MP; m += C.ngw) { const float rs = 1.0f / sqrtf(ss4[m] * (1.0f / 2048.0f) + 1e-6f); f32x4* xr = (f32x4*)(a.out + (size_t)m * DM);
#pragma unroll
        for (int j = 0; j < 8; ++j) { const f32x4 v = xr[C.lane + 64 * j], g = *((const f32x4*)gf + C.lane + 64 * j); xr[C.lane + 64 * j] = v * rs * g; } }
    const float* slab = (const float*)(a.ws + WS_PRW); LAS float* red = (LAS float*)C.lds;
    for (int r = blockIdx.x; r < NSAMP; r += gridDim.x) { const int col = 4 * C.tid;
        f32x4 s = (f32x4){0.f, 0.f, 0.f, 0.f};
        for (int sl = 0; sl < nsl; ++sl) s += *(const f32x4*)(slab + ((size_t)sl * 128 + r) * DM + col);
        f32x4* xp = (f32x4*)(a.out + (size_t)(MP + r) * DM + col); const f32x4 x = *xp + s * 0.5f;
        const float ws_ = wave_sum(dot4(x, x));
        __syncthreads(); if (C.lane == 0) red[C.wave] = ws_; __syncthreads();
        float tot = 0.f;
#pragma unroll
        for (int w = 0; w < NWAVES; ++w) tot += red[w];
        const float rs = 1.0f / sqrtf(tot * (1.0f / 2048.0f) + 1e-6f);
        *xp = x * rs * *(const f32x4*)(gf + col); }
}
constexpr size_t WS_QF = WS_XB, WS_PF = WS_QKV, WS_SB = WS_QKV + 16 * MiB, WS_ORAWS = WS_QKV + 17 * MiB, WS_W2C = WS_WINT, WS_O0F = 393 * MiB, WS_HF = 425 * MiB, WS_END2 = 441 * MiB;
constexpr int CK_STR = 160;
constexpr int L_NB = 0, L_RB = 10240, L_BB = 20480, L_QB = 30720, L_VB = 40960, L_ANQ = 51200, L_ARB = 61440, L_ARQ = 71680, L_ANB = 81920, L_RHS = 98304, L_XT = 98304, L_GC = 131072 + 1024, L_SEG = 131072 + 2048;
__device__ __forceinline__ bf16x8 tr_frag(const LAS unsigned char* base, int row0, int col0, int fr) {
    const LAS unsigned char* p = base + (row0 + (fr >> 2)) * CK_STR + (col0 + 4 * (fr & 3)) * 2;
    const v4i16_t t0 = __builtin_amdgcn_ds_read_tr16_b64_v4i16((LAS v4i16_t*)p), t1 = __builtin_amdgcn_ds_read_tr16_b64_v4i16((LAS v4i16_t*)(p + 4 * CK_STR));
    bf16x8 r; r[0] = t0[0]; r[1] = t0[1]; r[2] = t0[2]; r[3] = t0[3]; r[4] = t1[0]; r[5] = t1[1]; r[6] = t1[2]; r[7] = t1[3]; return r;
}
__device__ __forceinline__ bf16x8 row_frag(const LAS unsigned char* base, int row, int c0) { return *(const LAS bf16x8*)(base + row * CK_STR + c0 * 2); }
__device__ __forceinline__ f32x4 exp2_4(f32x4 x) { return (f32x4){__builtin_amdgcn_exp2f(x[0]), __builtin_amdgcn_exp2f(x[1]), __builtin_amdgcn_exp2f(x[2]), __builtin_amdgcn_exp2f(x[3])}; }
__device__ __forceinline__ v2u pk4(f32x4 x) { v2u o; o.x = pk2(x[0], x[1]); o.y = pk2(x[2], x[3]); return o; }

__device__ __forceinline__ void chunk_solve(float (&X)[16], const LAS float* ANB, const LAS float* RHS, int w, int lane) {
    const int col = 16 * w + (lane >> 2), sp = lane & 3;
#pragma unroll
    for (int i = 0; i < 16; ++i) X[i] = 0.f;
#pragma unroll
    for (int t = 0; t < 64; ++t) { float part = 0.f; const LAS float* ar = ANB + t * 64 + sp * 16;
#pragma unroll
        for (int i4 = 0; i4 < (t + 15) / 16; ++i4) { const f32x4 a4 = *(const LAS f32x4*)(ar + 4 * i4);
            part += (a4[0] * X[4 * i4] + a4[1] * X[4 * i4 + 1]) + (a4[2] * X[4 * i4 + 2] + a4[3] * X[4 * i4 + 3]); }
        part += dpp_f<0xB1>(part); part += dpp_f<0x4E>(part);
        const float xt = RHS[t * 128 + col] + part;
        X[t >> 2] = (sp == (t & 3)) ? xt : X[t >> 2]; }
}

__device__ __forceinline__ void phase_chunkA(const Ctx& C, const Args& a) {
    unsigned char* ws = a.ws;
    const float* PRW = (const float*)(ws + WS_PRW); const float* ZROW = (const float*)(ws + WS_CTL) + CW_ZROW;
    const float* LWW = (const float*)(ws + WS_LWW); const float* LWA = (const float*)(ws + WS_LWA);
    v4u* PF = (v4u*)(ws + WS_PF); f32x4* QF = (f32x4*)(ws + WS_QF); bf16* W2C = (bf16*)(ws + WS_W2C); f32x4* O0F = (f32x4*)(ws + WS_O0F); float* SBN = (float*)(ws + WS_SB);
    const RwConst rc{a.in[I_MU], a.in[I_KK], a.in[I_KA]};
    LAS unsigned char* L = C.lds; const int tid = C.tid, lane = C.lane, w = C.wave, fr = lane & 15, fq = lane >> 4;
    LAS float* RHS = (LAS float*)(L + L_RHS); LAS float* ANB = (LAS float*)(L + L_ANB); LAS float* GC = (LAS float*)(L + L_GC); LAS float* SEG = (LAS float*)(L + L_SEG);
#pragma unroll 1
    for (int item = blockIdx.x; item < 2048; item += gridDim.x) {
        const int chain = item >> 5, c = item & 31, b = chain >> 4, h = chain & 15; const size_t m0 = (size_t)b * TSEQ + c * 64;
        const int kg = tid & 15, tq = tid >> 4, hk = h * 64 + 4 * kg;
        f32x4 vn[2], vb_[2], vq[2], vr[2];
        {   const f32x4 mr = *(const f32x4*)(rc.mu + hk), mk = *(const f32x4*)(rc.mu + 1024 + hk), mv = *(const f32x4*)(rc.mu + 2048 + hk), kk4 = *(const f32x4*)(rc.k_k + hk), ka4 = *(const f32x4*)(rc.k_a + hk), rk4 = *(const f32x4*)(a.in[I_RK] + hk);
#pragma unroll
            for (int u = 0; u < 2; ++u) { const int t = tq + 32 * u; const size_t m = m0 + t; const float* prow = PRW + m * NRWP; const float* pp = (c == 0 && t == 0) ? ZROW : prow - NRWP;
                const f32x4 pr = *(const f32x4*)(prow + hk), pk = *(const f32x4*)(prow + 1024 + hk), pv = *(const f32x4*)(prow + 2048 + hk);
                const f32x4 qr = *(const f32x4*)(pp + hk), qk = *(const f32x4*)(pp + 1024 + hk), qv = *(const f32x4*)(pp + 2048 + hk);
                const f32x4 xw = *(const f32x4*)(LWW + m * 1024 + hk), xa = *(const f32x4*)(LWA + m * 1024 + hk);
                const f32x4 ur = pr + mr * (qr - pr), uk = pk + mk * (qk - pk), uv = pv + mv * (qv - pv);
                const f32x4 kk = uk * kk4; const float n2 = red16(dot4(kk, kk)); const float inv = 1.0f / fmaxf(sqrtf(n2), 1e-12f); const f32x4 kkn = kk * inv;
                const f32x4 aa = sig4(xa);
                vn[u] = -kkn; vb_[u] = kkn * aa; vq[u] = uk * (1.0f + (aa - 1.0f) * ka4); vr[u] = ur;
                const float sb = red16(dot4(vr[u] * vq[u], rk4)); if (kg == 0) SBN[(size_t)item * 64 + t] = sb;
                *(LAS f32x4*)(RHS + t * 128 + 64 + 4 * kg) = sig4(xw) * -0.8750387749f;
                *(LAS v2u*)(L + L_VB + t * CK_STR + 8 * kg) = pk4(uv); } }
        __syncthreads();
        {
            const int k = tid & 63, sg = tid >> 6; LAS float* cp = RHS + (8 * sg) * 128 + 64 + k; float run = 0.f; float v8[8];
#pragma unroll
            for (int i = 0; i < 8; ++i) { run += cp[i * 128]; v8[i] = run; }
            SEG[sg * 64 + k] = run;
            __syncthreads();
            float off = 0.f;
#pragma unroll
            for (int s = 0; s < 7; ++s) off += (s < sg) ? SEG[s * 64 + k] : 0.f;
#pragma unroll
            for (int i = 0; i < 8; ++i) cp[i * 128] = v8[i] + off; }
        __syncthreads();
#pragma unroll
        for (int u = 0; u < 2; ++u) { const int t = tq + 32 * u;
            const f32x4 csT = *(const LAS f32x4*)(RHS + t * 128 + 64 + 4 * kg); f32x4 csP = (f32x4){0.f, 0.f, 0.f, 0.f}; if (t > 0) csP = *(const LAS f32x4*)(RHS + (t - 1) * 128 + 64 + 4 * kg);
            const f32x4 eT = exp2_4(csT), eP = exp2_4(csP), eI = exp2_4(-csT); const f32x4 nt = vn[u] * eP;
            *(LAS f32x4*)(RHS + t * 128 + 4 * kg) = nt;
            *(LAS v2u*)(L + L_NB + t * CK_STR + 8 * kg) = pk4(nt); *(LAS v2u*)(L + L_RB + t * CK_STR + 8 * kg) = pk4(vr[u] * eT);
            *(LAS v2u*)(L + L_BB + t * CK_STR + 8 * kg) = pk4(vb_[u] * eI); *(LAS v2u*)(L + L_QB + t * CK_STR + 8 * kg) = pk4(vq[u] * eI);
            if (t == 63) *(LAS f32x4*)(GC + 4 * kg) = eT; }
        __syncthreads();
        {   const bool isN = w < 4; const LAS unsigned char* tb = L + (isN ? L_NB : L_RB); const int t = 16 * (w & 3) + fr;
            const bf16x8 bt0 = row_frag(tb, t, 8 * fq), bt1 = row_frag(tb, t, 8 * fq + 32);
#pragma unroll
            for (int jt8 = 0; jt8 < 8; ++jt8) { const LAS unsigned char* jb = L + (jt8 < 4 ? L_BB : L_QB); const int jt = jt8 & 3;
                const bf16x8 a0 = row_frag(jb, 16 * jt + fr, 8 * fq), a1 = row_frag(jb, 16 * jt + fr, 8 * fq + 32);
                f32x4 acc = (f32x4){0.f, 0.f, 0.f, 0.f};
                acc = __builtin_amdgcn_mfma_f32_16x16x32_bf16(a0, bt0, acc, 0, 0, 0); acc = __builtin_amdgcn_mfma_f32_16x16x32_bf16(a1, bt1, acc, 0, 0, 0);
#pragma unroll
                for (int r = 0; r < 4; ++r) { const int j = 16 * jt + 4 * fq + r; const bool keep = isN ? (j < t) : (j <= t); acc[r] = keep ? acc[r] : 0.f; }
                if (isN && jt8 < 4) {
#pragma unroll
                    for (int r = 0; r < 4; ++r) ANB[t * 64 + r * 16 + 4 * jt + fq] = acc[r];
                } else { const int dst = isN ? L_ANQ : (jt8 < 4 ? L_ARB : L_ARQ); *(LAS v2u*)(L + dst + t * CK_STR + (16 * jt + 4 * fq) * 2) = pk4(acc); } } }
        __syncthreads();
        {   const int tt = w & 3, t = 16 * tt + fr;
            const bf16x8 b0 = row_frag(L + L_ANQ, t, 8 * fq), b1 = row_frag(L + L_ANQ, t, 8 * fq + 32);
#pragma unroll
            for (int q = 0; q < 2; ++q) { const int vt = 2 * (w >> 2) + q;
                const bf16x8 a0 = tr_frag(L + L_VB, 8 * fq, 16 * vt, fr), a1 = tr_frag(L + L_VB, 32 + 8 * fq, 16 * vt, fr);
                f32x4 acc = (f32x4){0.f, 0.f, 0.f, 0.f};
                acc = __builtin_amdgcn_mfma_f32_16x16x32_bf16(a0, b0, acc, 0, 0, 0); acc = __builtin_amdgcn_mfma_f32_16x16x32_bf16(a1, b1, acc, 0, 0, 0);
                *(LAS f32x4*)(RHS + t * 128 + 64 + 16 * vt + 4 * fq) = acc; } }
        __syncthreads();
        float X[16];
        chunk_solve(X, ANB, RHS, w, lane);
#if defined(SOLVE_REP) && SOLVE_REP > 1
        { float X2[16]; chunk_solve(X2, ANB, RHS, w, lane);
#pragma unroll
          for (int i = 0; i < 16; ++i) X[i] = 0.5f * (X[i] + X2[i]); }
#endif
        __syncthreads();
        {   const int col = 16 * w + (lane >> 2), sp = lane & 3; LAS unsigned short* xp = (LAS unsigned short*)(L + L_XT + col * CK_STR) + sp;
#pragma unroll
            for (int i = 0; i < 16; ++i) xp[4 * i] = (unsigned short)f2bf(X[i]); }
        __syncthreads();
#ifndef S5_REP
#define S5_REP 1
#endif
#pragma unroll 1
        for (int rep5 = 0; rep5 < S5_REP; ++rep5)
        {   const LAS unsigned char* XT = L + L_XT; const int t4 = w & 3, hi = w >> 2;
            {   const int t = 16 * t4 + fr; const bf16x8 b0 = row_frag(L + L_ARB, t, 8 * fq), b1 = row_frag(L + L_ARB, t, 8 * fq + 32);
#pragma unroll
                for (int q = 0; q < 2; ++q) { const int kt = 2 * hi + q;
                    const bf16x8 a0 = row_frag(XT, 16 * kt + fr, 8 * fq), a1 = row_frag(XT, 16 * kt + fr, 8 * fq + 32);
                    f32x4 acc = (f32x4){0.f, 0.f, 0.f, 0.f};
                    acc = __builtin_amdgcn_mfma_f32_16x16x32_bf16(a0, b0, acc, 0, 0, 0); acc = __builtin_amdgcn_mfma_f32_16x16x32_bf16(a1, b1, acc, 0, 0, 0);
                    const v2u rt = *(const LAS v2u*)(L + L_RB + t * CK_STR + (16 * kt + 4 * fq) * 2);
                    acc += (f32x4){bflo(rt.x), bfhi(rt.x), bflo(rt.y), bfhi(rt.y)};
                    *(v2u*)(W2C + ((size_t)item * 64 + t) * 64 + 16 * kt + 4 * fq) = pk4(acc); } }
            {   const int t = 16 * t4 + fr; const bf16x8 a0 = row_frag(L + L_ARB, t, 8 * fq), a1 = row_frag(L + L_ARB, t, 8 * fq + 32), c0 = row_frag(L + L_ARQ, t, 8 * fq), c1 = row_frag(L + L_ARQ, t, 8 * fq + 32);
#pragma unroll
                for (int q = 0; q < 2; ++q) { const int vt = 2 * hi + q;
                    const bf16x8 u0 = row_frag(XT, 64 + 16 * vt + fr, 8 * fq), u1 = row_frag(XT, 64 + 16 * vt + fr, 8 * fq + 32);
                    const bf16x8 v0 = tr_frag(L + L_VB, 8 * fq, 16 * vt, fr), v1 = tr_frag(L + L_VB, 32 + 8 * fq, 16 * vt, fr);
                    f32x4 acc = (f32x4){0.f, 0.f, 0.f, 0.f};
                    acc = __builtin_amdgcn_mfma_f32_16x16x32_bf16(a0, u0, acc, 0, 0, 0); acc = __builtin_amdgcn_mfma_f32_16x16x32_bf16(a1, u1, acc, 0, 0, 0);
                    acc = __builtin_amdgcn_mfma_f32_16x16x32_bf16(c0, v0, acc, 0, 0, 0); acc = __builtin_amdgcn_mfma_f32_16x16x32_bf16(c1, v1, acc, 0, 0, 0);
                    O0F[(((size_t)item * 4 + t4) * 4 + vt) * 64 + lane] = acc; } }
            {   const int kt = t4, s = hi; const bf16x8 b0 = tr_frag(L + L_BB, 8 * fq, 16 * kt, fr), b1 = tr_frag(L + L_BB, 32 + 8 * fq, 16 * kt, fr);
                const float g = GC[16 * kt + fr]; unsigned pw[4];
#pragma unroll
                for (int q = 0; q < 2; ++q) { const int ct = 2 * s + q;
                    const bf16x8 a0 = row_frag(XT, 16 * ct + fr, 8 * fq), a1 = row_frag(XT, 16 * ct + fr, 8 * fq + 32);
                    f32x4 acc = (f32x4){0.f, 0.f, 0.f, 0.f};
                    acc = __builtin_amdgcn_mfma_f32_16x16x32_bf16(a0, b0, acc, 0, 0, 0); acc = __builtin_amdgcn_mfma_f32_16x16x32_bf16(a1, b1, acc, 0, 0, 0);
#pragma unroll
                    for (int r = 0; r < 4; ++r) { const int kp = 16 * ct + 4 * fq + r; acc[r] = g * (acc[r] + ((kp == 16 * kt + fr) ? 1.0f : 0.0f)); }
                    pw[2 * q] = pk2(acc[0], acc[1]); pw[2 * q + 1] = pk2(acc[2], acc[3]); }
                PF[(((size_t)item * 4 + kt) * 2 + s) * 64 + lane] = (v4u){pw[0], pw[1], pw[2], pw[3]}; }
            {   const int kt = t4; const bf16x8 a0 = tr_frag(L + L_BB, 8 * fq, 16 * kt, fr), a1 = tr_frag(L + L_BB, 32 + 8 * fq, 16 * kt, fr), c0 = tr_frag(L + L_QB, 8 * fq, 16 * kt, fr), c1 = tr_frag(L + L_QB, 32 + 8 * fq, 16 * kt, fr);
                const f32x4 g4 = *(const LAS f32x4*)(GC + 16 * kt + 4 * fq);
#pragma unroll
                for (int q = 0; q < 2; ++q) { const int vt = 2 * hi + q;
                    const bf16x8 u0 = row_frag(XT, 64 + 16 * vt + fr, 8 * fq), u1 = row_frag(XT, 64 + 16 * vt + fr, 8 * fq + 32);
                    const bf16x8 v0 = tr_frag(L + L_VB, 8 * fq, 16 * vt, fr), v1 = tr_frag(L + L_VB, 32 + 8 * fq, 16 * vt, fr);
                    f32x4 acc = (f32x4){0.f, 0.f, 0.f, 0.f};
                    acc = __builtin_amdgcn_mfma_f32_16x16x32_bf16(a0, u0, acc, 0, 0, 0); acc = __builtin_amdgcn_mfma_f32_16x16x32_bf16(a1, u1, acc, 0, 0, 0);
                    acc = __builtin_amdgcn_mfma_f32_16x16x32_bf16(c0, v0, acc, 0, 0, 0); acc = __builtin_amdgcn_mfma_f32_16x16x32_bf16(c1, v1, acc, 0, 0, 0);
                    QF[(((size_t)item * 4 + kt) * 4 + vt) * 64 + lane] = acc * g4; } } }
        __syncthreads();
    }
}

__device__ __forceinline__ void sample_wkv_items(const Ctx& C, const Args& a, int first, int stride) {
    unsigned char* ws = a.ws;
    const float* PRW = (const float*)(ws + WS_PRW); const float* LWW = (const float*)(ws + WS_LWW); const float* LWA = (const float*)(ws + WS_LWA); float* ORS = (float*)(ws + WS_ORAWS);
    const RwConst rc{a.in[I_MU], a.in[I_KK], a.in[I_KA]}; const int lane = C.lane;
    LAS float* vs = (LAS float*)(C.lds + C.wave * 16384);
    for (int it = first; it < NSAMP * 16; it += stride) { const int bs = it >> 4, hs = it & 15, kg = lane & 15, v_l = lane >> 4, hk = hs * 64 + 4 * kg; const size_t m = MP + bs;
        Ops o; prep_ops<true>(o, PRW + m * NRWP, a.in[I_SSHIFT] + (size_t)bs * NRW, LWW + m * 1024, LWA + m * 1024, rc, hk);
        if (v_l == 0) *(LAS f32x4*)(vs + 4 * kg) = o.v;
        LDS_WAIT(); asm volatile("" ::: "memory");
        const float* s0 = a.in[I_SWKV] + (size_t)(bs * 16 + hs) * 4096; float* s1 = a.out + O_SWKV + (size_t)(bs * 16 + hs) * 4096;
#pragma unroll 4
        for (int i = 0; i < 16; ++i) { const int row = 4 * i + v_l; const f32x4 S4 = *(const f32x4*)(s0 + row * 64 + 4 * kg);
            const float sa = red16(dot4(S4, o.na)); const float vv = vs[row];
            const f32x4 Sn = S4 * o.w + (o.b * sa + o.kp * vv);
            *(f32x4*)(s1 + row * 64 + 4 * kg) = Sn;
            const float ov = red16(dot4(Sn, o.r));
            if (kg == 0) ORS[(size_t)bs * 1024 + hs * 64 + row] = ov; }
        LDS_WAIT(); asm volatile("" ::: "memory"); }
}
__device__ __forceinline__ void phase_chunkB(const Ctx& C, const Args& a) {
    unsigned char* ws = a.ws;
    const v4u* PF = (const v4u*)(ws + WS_PF); const f32x4* QF = (const f32x4*)(ws + WS_QF); v4u* HF = (v4u*)(ws + WS_HF);
    const int lane = C.lane, w = C.wave, fr = lane & 15, fq = lane >> 4;
    const int nchainwg = gridDim.x < 64 ? gridDim.x : 64;
    if ((int)blockIdx.x < nchainwg && w < 4) {
#pragma unroll 1
        for (int chain = blockIdx.x; chain < 64; chain += nchainwg) {
            f32x4 H[4];
#pragma unroll
            for (int kt = 0; kt < 4; ++kt) H[kt] = (f32x4){0.f, 0.f, 0.f, 0.f};
            const size_t it0 = (size_t)chain * 32;
            v4u pf[4][2]; f32x4 qf[4];
#pragma unroll
            for (int kt = 0; kt < 4; ++kt) { qf[kt] = QF[((it0 * 4 + kt) * 4 + w) * 64 + lane]; pf[kt][0] = PF[((it0 * 4 + kt) * 2 + 0) * 64 + lane]; pf[kt][1] = PF[((it0 * 4 + kt) * 2 + 1) * 64 + lane]; }
#pragma unroll 1
            for (int c = 0; c < 32; ++c) { const size_t item = it0 + c;
                union { bf16x8 v; v4u u; } hb0, hb1;
                hb0.u = (v4u){pk2(H[0][0], H[0][1]), pk2(H[0][2], H[0][3]), pk2(H[1][0], H[1][1]), pk2(H[1][2], H[1][3])};
                hb1.u = (v4u){pk2(H[2][0], H[2][1]), pk2(H[2][2], H[2][3]), pk2(H[3][0], H[3][1]), pk2(H[3][2], H[3][3])};
                HF[((item * 4 + w) * 2 + 0) * 64 + lane] = hb0.u; HF[((item * 4 + w) * 2 + 1) * 64 + lane] = hb1.u;
                v4u pn[4][2]; f32x4 qn[4];
                if (c + 1 < 32) {
#pragma unroll
                    for (int kt = 0; kt < 4; ++kt) { qn[kt] = QF[(((item + 1) * 4 + kt) * 4 + w) * 64 + lane]; pn[kt][0] = PF[(((item + 1) * 4 + kt) * 2 + 0) * 64 + lane]; pn[kt][1] = PF[(((item + 1) * 4 + kt) * 2 + 1) * 64 + lane]; } }
#pragma unroll
                for (int kt = 0; kt < 4; ++kt) { union { bf16x8 v; v4u u; } p0, p1; p0.u = pf[kt][0]; p1.u = pf[kt][1];
                    f32x4 acc = qf[kt];
                    acc = __builtin_amdgcn_mfma_f32_16x16x32_bf16(p0.v, hb0.v, acc, 0, 0, 0); acc = __builtin_amdgcn_mfma_f32_16x16x32_bf16(p1.v, hb1.v, acc, 0, 0, 0);
                    H[kt] = acc; }
                if (c + 1 < 32) {
#pragma unroll
                    for (int kt = 0; kt < 4; ++kt) { qf[kt] = qn[kt]; pf[kt][0] = pn[kt][0]; pf[kt][1] = pn[kt][1]; } } }
            const int b = chain >> 4, h = chain & 15;
#pragma unroll
            for (int kt = 0; kt < 4; ++kt) *(f32x4*)(a.out + O_PWKV + ((size_t)(b * 16 + h) * 64 + 16 * w + fr) * 64 + 16 * kt + 4 * fq) = H[kt];
        }
    } else {
        const int nw = (int)gridDim.x * NWAVES - nchainwg * 4;
        const int idx = (int)blockIdx.x < nchainwg ? (int)blockIdx.x * 4 + (w - 4) : nchainwg * 4 + ((int)blockIdx.x - nchainwg) * NWAVES + w;
        sample_wkv_items(C, a, idx, nw);
        if ((int)blockIdx.x >= nchainwg) convert_ffn(C, a.in[I_W2G], a.in[I_W2U], a.in[I_W2D], a.in[I_N2], (bf16*)(ws + WS_W1T), (bf16*)(ws + WS_W2T), ((int)blockIdx.x - nchainwg) * NWAVES + w, ((int)gridDim.x - nchainwg) * NWAVES, 0, CONV_SPLIT);
    }
}
__device__ __forceinline__ void phase_chunkC(const Ctx& C, const Args& a) {
    unsigned char* ws = a.ws;
    const float* PRW = (const float*)(ws + WS_PRW); const float* ZROW = (const float*)(ws + WS_CTL) + CW_ZROW; const bf16* LWG = (const bf16*)(ws + WS_LWG);
    const bf16* W2C = (const bf16*)(ws + WS_W2C); const f32x4* O0F = (const f32x4*)(ws + WS_O0F); const v4u* HF = (const v4u*)(ws + WS_HF); const float* SBN = (const float*)(ws + WS_SB); bf16* OMIX = (bf16*)(ws + WS_OMIX);
    const int lane = C.lane, fr = lane & 15, fq = lane >> 4;
#pragma unroll 1
    for (int task = C.gw; task < 2048 * 4; task += C.ngw) { const int item = task >> 2, tt = task & 3, chain = item >> 5, c = item & 31, b = chain >> 4, h = chain & 15;
        const size_t m0 = (size_t)b * TSEQ + c * 64 + 16 * tt;
        const bf16* wr = W2C + ((size_t)item * 64 + 16 * tt + fr) * 64 + 4 * fq;
        union { bf16x8 v; v2u u[2]; } a0, a1; a0.u[0] = *(const v2u*)(wr); a0.u[1] = *(const v2u*)(wr + 16); a1.u[0] = *(const v2u*)(wr + 32); a1.u[1] = *(const v2u*)(wr + 48);
        f32x4 o[4];
#pragma unroll
        for (int vt = 0; vt < 4; ++vt) { union { bf16x8 v; v4u u; } h0, h1; h0.u = HF[(((size_t)item * 4 + vt) * 2 + 0) * 64 + lane]; h1.u = HF[(((size_t)item * 4 + vt) * 2 + 1) * 64 + lane];
            f32x4 acc = O0F[(((size_t)item * 4 + tt) * 4 + vt) * 64 + lane];
            acc = __builtin_amdgcn_mfma_f32_16x16x32_bf16(a0.v, h0.v, acc, 0, 0, 0); acc = __builtin_amdgcn_mfma_f32_16x16x32_bf16(a1.v, h1.v, acc, 0, 0, 0);
            o[vt] = acc; }
        const float* muv = a.in[I_MU] + 2048 + h * 64;
#pragma unroll
        for (int r = 0; r < 4; ++r) { const size_t m = m0 + 4 * fq + r;
            const float mean = red16((o[0][r] + o[1][r]) + (o[2][r] + o[3][r])) * (1.0f / 64.0f);
            const float d0 = o[0][r] - mean, d1 = o[1][r] - mean, d2 = o[2][r] - mean, d3 = o[3][r] - mean;
            const float var = red16((d0 * d0 + d1 * d1) + (d2 * d2 + d3 * d3)) * (1.0f / 64.0f); const float rstd = 1.0f / sqrtf(var + 64e-5f);
            const float sb = SBN[(size_t)item * 64 + 16 * tt + 4 * fq + r];
            const float* prow = PRW + m * NRWP + 2048 + h * 64; const float* pp = ((m & 2047) == 0) ? ZROW + 2048 + h * 64 : prow - NRWP;
            const float dd[4] = {d0, d1, d2, d3};
#pragma unroll
            for (int vt = 0; vt < 4; ++vt) { const int v = 16 * vt + fr; const float pv = prow[v]; const float uv = pv + muv[v] * (pp[v] - pv);
                const float g = bf2f(LWG[m * 1024 + h * 64 + v]);
                const float res = (dd[vt] * rstd * a.in[I_LNG][h * 64 + v] + a.in[I_LNB][h * 64 + v] + uv * sb) * g;
                OMIX[m * DM + h * 64 + v] = (bf16)f2bf(res); } } }
    { const float* LWA = (const float*)(ws + WS_LWA); const float* ORS = (const float*)(ws + WS_ORAWS); const RwConst rc{a.in[I_MU], a.in[I_KK], a.in[I_KA]}; const int kg = lane & 15;
      for (int g = C.gw * 4 + (lane >> 4); g < NSAMP * 16; g += C.ngw * 4) { const int bs = g >> 4, h = g & 15, hk = h * 64 + 4 * kg; const size_t m = MP + bs;
        Ops o; prep_ops<false>(o, PRW + m * NRWP, a.in[I_SSHIFT] + (size_t)bs * NRW, nullptr, LWA + m * 1024, rc, hk);
        const f32x4 rk = *(const f32x4*)(a.in[I_RK] + hk);
        const float sb = red16(dot4(o.r * o.kp, rk));
        const f32x4 o4 = *(const f32x4*)(ORS + (size_t)bs * 1024 + hk);
        const float mean = red16((o4[0] + o4[1]) + (o4[2] + o4[3])) * (1.0f / 64.0f); const f32x4 d = o4 - mean;
        const float var = red16(dot4(d, d)) * (1.0f / 64.0f); const float rstd = 1.0f / sqrtf(var + 64e-5f);
        const f32x4 lg = *(const f32x4*)(a.in[I_LNG] + hk), lb = *(const f32x4*)(a.in[I_LNB] + hk);
        const v2u gw2 = *(const v2u*)(LWG + m * 1024 + hk); const f32x4 g4 = (f32x4){bflo(gw2.x), bfhi(gw2.x), bflo(gw2.y), bfhi(gw2.y)};
        const f32x4 res = (d * rstd * lg + lb + o.v * sb) * g4;
        *(v2u*)(OMIX + m * DM + hk) = pk4(res); } }
}
__global__ void __launch_bounds__(NWAVES * 64, 2) mk_fwd(Args a_kernarg) {
    const Args& a = *(const Args*)__builtin_amdgcn_kernarg_segment_ptr();
    extern __shared__ __attribute__((aligned(16))) unsigned char lds_raw[];
    Ctx C; C.lds = (LAS unsigned char*)lds_raw; C.tid = threadIdx.x; C.lane = C.tid & 63; C.wave = __builtin_amdgcn_readfirstlane(C.tid >> 6);
    const int G = gridDim.x, bx = blockIdx.x, vcu = (G % 8 == 0) ? (bx % 8) * (G / 8) + bx / 8 : bx;
    C.gw = vcu * NWAVES + C.wave; C.ngw = G * NWAVES;
    volatile LAS unsigned* MISC = (volatile LAS unsigned*)(C.lds + MISC_OFF);
    for (int u = C.tid; u < (LDS_BYTES - LDSCTL_OFF) / 4; u += NWAVES * 64) ((LAS unsigned*)(C.lds + LDSCTL_OFF))[u] = 0u;
    __syncthreads();
    unsigned char* ws = a.ws; unsigned* ctl = (unsigned*)(ws + WS_CTL);
    const int lo = a.ph_lo, hi = a.ph_hi;
    XcdBarrier bar; bar.bar = ctl + CW_BAR; bar.x = 0; bar.st = nullptr;
    if (hi - lo > 1) bar = xcd_barrier_post(ctl + CW_BAR, MISC + 8);
#ifndef PH_MASK
#define PH_MASK 0x3FFF
#endif
#define IN(k) (((PH_MASK >> (k)) & 1) && lo <= (k) && (k) < hi)
#define SEAM(k) do { if (IN(k) && IN((k) + 1)) xcd_barrier(bar); } while (0)
#ifndef DUP_MASK
#define DUP_MASK 0
#endif
#define DUP(k) (((DUP_MASK >> (k)) & 1) != 0)
    float* ssb = (float*)ctl + CW_SS;
    bf16* XB = (bf16*)(ws + WS_XB); bf16* HB = (bf16*)(ws + WS_H); bf16* OMIX = (bf16*)(ws + WS_OMIX);
    LAS unsigned char* ring = C.lds;

    if (IN(0)) { for (int rep = 0; rep < (DUP(0) ? 2 : 1); ++rep) { if (rep) xcd_barrier(bar); phase_prologue(C, a); } SEAM(0); }
    if (IN(1)) {
#ifndef GEMM1_DUP
#define GEMM1_DUP 1
#endif
        pg8::Gemm g{XB, (const bf16*)(ws + WS_W1T), MPAD, 2 * FF, DM}; pg8::DupOrder S; S.init(MPAD, 2 * FF, DM, G, bx); S.rep = GEMM1_DUP;
        pg8::EpiSwiglu E{HB, ssb, FF};
        pg8::gemm_phase<pg8::EpiSwiglu, pg8::DupOrder, true, true>(ring, g, S, E); SEAM(1); }
    if (IN(2)) {
        pg8::Gemm g{HB, (const bf16*)(ws + WS_W2T), MPAD, DM, FF}; pg8::SliceOrder S; S.init(FF, G, bx);
        pg8::EpiResid E{a.in[I_XP], a.out, XB, ssb + SS_STRIDE, 0.5f, (float*)(ws + WS_PRW)};
        pg8::gemm_phase<pg8::EpiResid, pg8::SliceOrder, true, true>(ring, g, S, E); SEAM(2); }
    if (IN(3)) { phase_reduce(C, a, FF / 256, a.in[I_XS], 0.5f, ssb + SS_STRIDE); SEAM(3); }
    if (IN(4)) {
        pg8::Gemm g{XB, (const bf16*)(ws + WS_WINT), MPAD, NIN, DM}; pg8::StaticOrder S; S.init(MPAD, NIN, DM, G, bx);
        pg8::EpiWin E{(bf16*)(ws + WS_QKV), (float*)(ws + WS_PRW), ssb + SS_STRIDE, a.out + O_PKWIN, (long)(O_SKWIN - O_PKWIN), QSCALE};
        pg8::gemm_phase<pg8::EpiWin, pg8::StaticOrder, true, true>(ring, g, S, E); SEAM(4); }
    if (IN(5)) { for (int rep = 0; rep < (DUP(5) ? 2 : 1); ++rep) { if (rep) xcd_barrier(bar); phase_mixprep(C, a); } SEAM(5); }
    if (IN(6)) {
        pg8::Gemm g{(const bf16*)(ws + WS_ALORA), (const bf16*)(ws + WS_WLT), MPAD, NL, KL}; pg8::StaticOrder S; S.init(MPAD, NL, KL, G, bx);
        pg8::EpiLora E{(float*)(ws + WS_LWW), (long)((WS_LWA - WS_LWW) / 4), (bf16*)(ws + WS_LWG), a.in[I_DBASE], (long)(a.in[I_IBASE] - a.in[I_DBASE])};
        pg8::gemm_phase<pg8::EpiLora, pg8::StaticOrder, true, true>(ring, g, S, E); SEAM(6); }
#ifndef CH_DUP
#define CH_DUP 0
#endif
    if (IN(7)) { phase_chunkA(C, a); if (CH_DUP & 1) { xcd_barrier(bar); phase_chunkA(C, a); } SEAM(7); }
    if (IN(8)) { phase_chunkB(C, a); if (CH_DUP & 2) { xcd_barrier(bar); phase_chunkB(C, a); } xcd_barrier(bar); phase_chunkC(C, a); if (CH_DUP & 4) { xcd_barrier(bar); phase_chunkC(C, a); } SEAM(8); }
    if (IN(9)) {
        pg8::Gemm g{OMIX, (const bf16*)(ws + WS_WOUTT), MPAD, DM, DM}; pg8::SliceOrder S; S.init(DM, G, bx);
        pg8::EpiResid E{a.out, a.out, XB, ssb + 2 * SS_STRIDE, 1.0f, (float*)(ws + WS_PRW)};
        pg8::gemm_phase<pg8::EpiResid, pg8::SliceOrder, true, true>(ring, g, S, E); SEAM(9); }
    if (IN(10)) { phase_reduce(C, a, DM / 256, a.out + (size_t)MP * DM, 1.0f, ssb + 2 * SS_STRIDE); SEAM(10); }
    if (IN(11)) {
        pg8::Gemm g{XB, (const bf16*)(ws + WS_W1T), MPAD, 2 * FF, DM}; pg8::StaticOrder S; S.init(MPAD, 2 * FF, DM, G, bx);
        pg8::EpiSwiglu E{HB, ssb + 2 * SS_STRIDE, FF};
        pg8::gemm_phase<pg8::EpiSwiglu, pg8::StaticOrder, true, true>(ring, g, S, E); SEAM(11); }
    if (IN(12)) {
        pg8::Gemm g{HB, (const bf16*)(ws + WS_W2T), MPAD, DM, FF}; pg8::SliceOrder S; S.init(FF, G, bx);
        pg8::EpiResid E{a.out, a.out, nullptr, ssb + 3 * SS_STRIDE, 0.5f, (float*)(ws + WS_PRW)};
        pg8::gemm_phase<pg8::EpiResid, pg8::SliceOrder, true, true>(ring, g, S, E); SEAM(12); }
#ifdef XBAR_EXTRA
    for (int xb = 0; xb < XBAR_EXTRA; ++xb) xcd_barrier(bar);
#endif
    if (IN(13)) { phase_final(C, a, FF / 256); }
#undef IN
#undef SEAM
}

extern "C" void kernel_launch(void* const* d_in, const int* in_sizes, int n_in, void* d_out, int out_size, void* d_ws, size_t ws_size, hipStream_t stream) {
    static int grid = 0;
    if (grid == 0) {
        if (n_in != 30 || out_size != (int)O_END || ws_size < WS_END2) { fprintf(stderr, "kernel_launch: unexpected shapes: n_in %d out %d ws %zu (need %zu)\n", n_in, out_size, ws_size, (size_t)WS_END2); grid = -1; return; }
        int dev = 0, cus = 0;
        if (hipGetDevice(&dev) != hipSuccess || hipDeviceGetAttribute(&cus, hipDeviceAttributeMultiprocessorCount, dev) != hipSuccess) { grid = -1; return; }
        if (hipFuncSetAttribute((const void*)mk_fwd, hipFuncAttributeMaxDynamicSharedMemorySize, LDS_BYTES) != hipSuccess) { fprintf(stderr, "kernel_launch: hipFuncSetAttribute failed\n"); grid = -1; return; }
        int per_cu = 0;
        if (hipOccupancyMaxActiveBlocksPerMultiprocessor(&per_cu, (const void*)mk_fwd, NWAVES * 64, LDS_BYTES) != hipSuccess || per_cu < 1) fprintf(stderr, "kernel_launch: occupancy query says %d\n", per_cu);
        (void)hipGetLastError();
        grid = cus;
    }
    if (grid < 0) return;
    if (hipMemsetAsync((char*)d_ws + WS_CTL, 0, CTL_ZERO_BYTES, stream) != hipSuccess) { fprintf(stderr, "kernel_launch: memset failed\n"); return; }
    Args a{};
    for (int i = 0; i < 30; ++i) a.in[i] = (const float*)d_in[i];
    a.out = (float*)d_out; a.ws = (unsigned char*)d_ws;
    if (MK_N_LAUNCHES == 1) { a.ph_lo = 0; a.ph_hi = N_PHASES; hipLaunchKernelGGL(mk_fwd, dim3(grid), dim3(NWAVES * 64), LDS_BYTES, stream, a); }
    else for (int p = 0; p < N_PHASES; ++p) { a.ph_lo = p; a.ph_hi = p + 1; hipLaunchKernelGGL(mk_fwd, dim3(grid), dim3(NWAVES * 64), LDS_BYTES, stream, a); }
    const hipError_t le = hipPeekAtLastError();
    if (le != hipSuccess) fprintf(stderr, "kernel_launch: launch failed: %s\n", hipGetErrorName(le));
}
```
